# Optimizing an MI355X kernel written in HIP

```python
import math
import jax
import jax.numpy as jnp
from jax import lax
import numpy as np

D_MODEL = 2048
BATCH = 1
SEQ = 16384
DEPTH = 1

D_MIX = D_MODEL
D_POOL = D_MIX // 2
POOL_WINDOWS = (2, 4, 8, 16)
N_POOL_GROUPS = len(POOL_WINDOWS)
POOL_GROUP = D_POOL // N_POOL_GROUPS
D_ATTN = D_MIX - D_POOL
HEAD_DIM = 128
N_HEADS = D_ATTN // HEAD_DIM
IDX_HEADS = 16
IDX_DIM = 64
TOPK_MAX = 256
Q_BLOCK = 128
D_FF = 5632
CONV_WIDTH = 3
EPS = 1e-6

D_IN = D_POOL + 3 * D_ATTN + IDX_HEADS * IDX_DIM + IDX_DIM + IDX_HEADS

kernel_name = "hybrid_pool_dsa_convffn_block"


def rmsnorm(x, g):
    xf = x.astype(jnp.float32)
    y = xf * lax.rsqrt(jnp.mean(xf * xf, axis=-1, keepdims=True) + EPS)
    return (y * g.astype(jnp.float32)).astype(x.dtype)


def pool_mixer(u, pool_w, pool_scale):
    B, S, C = u.shape
    uf = u.astype(jnp.float32)
    csum = jnp.concatenate([jnp.zeros((B, 1, C), jnp.float32), jnp.cumsum(uf, axis=1)], axis=1)
    t = jnp.arange(S)
    outs = []
    for gi, w in enumerate(POOL_WINDOWS):
        lo = jnp.maximum(t + 1 - w, 0)
        cnt = (t + 1 - lo).astype(jnp.float32)[None, :, None]
        c_g = csum[:, :, gi * POOL_GROUP:(gi + 1) * POOL_GROUP]
        mean = (c_g[:, 1:] - c_g[:, lo]) / cnt
        outs.append(mean - uf[:, :, gi * POOL_GROUP:(gi + 1) * POOL_GROUP])
    d = jnp.stack(outs, axis=2).astype(u.dtype)
    y = jnp.einsum('bsgc,gcd->bsgd', d, pool_w).reshape(B, S, C)
    return y * pool_scale


def dsa_attention(q, k, v, q_idx, k_idx, w_idx):
    B, S, H, Dh = q.shape
    topk = min(TOPK_MAX, S // 4)
    n_blocks = S // Q_BLOCK
    key_pos = jnp.arange(S)
    scale = Dh ** -0.5
    neg = jnp.finfo(jnp.float32).min

    def one_block(blk):
        start = blk * Q_BLOCK
        qb = lax.dynamic_slice_in_dim(q, start, Q_BLOCK, axis=1)
        qib = lax.dynamic_slice_in_dim(q_idx, start, Q_BLOCK, axis=1)
        wb = lax.dynamic_slice_in_dim(w_idx, start, Q_BLOCK, axis=1)
        q_pos = start + jnp.arange(Q_BLOCK)
        rel = jax.nn.relu(jnp.einsum('bthd,bsd->bths', qib.astype(jnp.float32), k_idx.astype(jnp.float32)))
        iscore = jnp.einsum('bths,bth->bts', rel, wb.astype(jnp.float32))
        causal = key_pos[None, :] <= q_pos[:, None]
        iscore = jnp.where(causal[None], iscore, neg)
        _, sel = lax.top_k(iscore, topk)
        valid = sel <= q_pos[None, :, None]
        k_sel = jax.vmap(lambda kb, ib: kb[ib])(k, sel)
        v_sel = jax.vmap(lambda vb, ib: vb[ib])(v, sel)
        s = jnp.einsum('bthd,btjhd->bhtj', qb, k_sel).astype(jnp.float32) * scale
        s = jnp.where(valid[:, None], s, neg)
        p = jax.nn.softmax(s, axis=-1).astype(v.dtype)
        return jnp.einsum('bhtj,btjhd->bthd', p, v_sel)

    out = lax.map(one_block, jnp.arange(n_blocks, dtype=jnp.int32))
    return jnp.transpose(out, (1, 0, 2, 3, 4)).reshape(B, S, H * Dh)


def conv_ffn(h, w_up, conv_w, conv_b, w_down):
    B, S, _ = h.shape
    up = h @ w_up
    up_p = jnp.pad(up, ((0, 0), (CONV_WIDTH - 1, 0), (0, 0)))
    c = conv_b + sum(conv_w[j] * up_p[:, j:j + S] for j in range(CONV_WIDTH))
    gate, val = jnp.split(c, 2, axis=-1)
    return (jax.nn.silu(gate) * val) @ w_down


def setup_inputs(seed: int = 0) -> dict:
    key = jax.random.key(seed)
    ks = jax.random.split(key, 14)
    f32 = jnp.float32
    nrm = lambda k, shape, s: jax.random.normal(k, shape, f32) * s
    return {
        "x": nrm(ks[0], (BATCH, SEQ, D_MODEL), 1.0),
        "attn_norm_g": 1.0 + nrm(ks[1], (D_MODEL,), 0.02),
        "w_in": nrm(ks[2], (D_MODEL, D_IN), D_MODEL ** -0.5),
        "pool_w": nrm(ks[3], (N_POOL_GROUPS, POOL_GROUP, POOL_GROUP), POOL_GROUP ** -0.5),
        "pool_scale": 1.0 + nrm(ks[4], (D_POOL,), 0.02),
        "q_norm_g": 1.0 + nrm(ks[5], (HEAD_DIM,), 0.02),
        "k_norm_g": 1.0 + nrm(ks[6], (HEAD_DIM,), 0.02),
        "w_out": nrm(ks[7], (D_MIX, D_MODEL), D_MIX ** -0.5),
        "ffn_norm_g": 1.0 + nrm(ks[8], (D_MODEL,), 0.02),
        "w_up": nrm(ks[9], (D_MODEL, 2 * D_FF), D_MODEL ** -0.5),
        "conv_w": nrm(ks[10], (CONV_WIDTH, 2 * D_FF), CONV_WIDTH ** -0.5),
        "conv_b": nrm(ks[11], (2 * D_FF,), 0.01),
        "w_down": nrm(ks[12], (D_FF, D_MODEL), D_FF ** -0.5),
    }


def reference(x, attn_norm_g, w_in, pool_w, pool_scale, q_norm_g, k_norm_g, w_out,
              ffn_norm_g, w_up, conv_w, conv_b, w_down):
    B, S, _ = x.shape
    for _layer in range(DEPTH):
        h = rmsnorm(x, attn_norm_g)
        z = h @ w_in
        o = 0
        u_pool = z[..., o:o + D_POOL]; o += D_POOL
        q = z[..., o:o + D_ATTN].reshape(B, S, N_HEADS, HEAD_DIM); o += D_ATTN
        k = z[..., o:o + D_ATTN].reshape(B, S, N_HEADS, HEAD_DIM); o += D_ATTN
        v = z[..., o:o + D_ATTN].reshape(B, S, N_HEADS, HEAD_DIM); o += D_ATTN
        q_idx = z[..., o:o + IDX_HEADS * IDX_DIM].reshape(B, S, IDX_HEADS, IDX_DIM); o += IDX_HEADS * IDX_DIM
        k_idx = z[..., o:o + IDX_DIM]; o += IDX_DIM
        w_idx = z[..., o:o + IDX_HEADS] * (IDX_HEADS ** -0.5) * (IDX_DIM ** -0.5)
        q = rmsnorm(q, q_norm_g)
        k = rmsnorm(k, k_norm_g)
        y_pool = pool_mixer(u_pool, pool_w, pool_scale)
        y_attn = dsa_attention(q, k, v, q_idx, k_idx, w_idx)
        x = x + jnp.concatenate([y_pool, y_attn], axis=-1) @ w_out
        x = x + conv_ffn(rmsnorm(x, ffn_norm_g), w_up, conv_w, conv_b, w_down)
    return x
```

```cpp
#include <hip/hip_runtime.h>
#include <hip/hip_cooperative_groups.h>
#include <cstdio>
#include <cstdint>
namespace cg = cooperative_groups;
namespace pg8 {
#define PG8_LAS __attribute__((address_space(3)))
typedef unsigned short bf16_t;
typedef short bf16x8 __attribute__((ext_vector_type(8)));
typedef float f32x4 __attribute__((ext_vector_type(4)));
typedef unsigned u32x4 __attribute__((ext_vector_type(4)));
constexpr int BM = 256, BK = 64, HALF = 128, HTB = HALF * BK * 2  , STAGE_BYTES = 8 * HTB, NXCD = 8, WGM = 8;

__host__ __device__ __forceinline__ int lds_byte(int r, int c) { const int st = (r >> 4) * 2 + (c >> 5), rr = r & 15, cc = c & 31, ob = rr * 64 + cc * 2; return st * 1024 + (ob ^ (((ob >> 9) & 1) << 5)); }
__host__ __device__ __forceinline__ void stage_rc(int b, int& R, int& C) { const int st = b / 1024, sb = b % 1024, swz = sb ^ (((sb >> 9) & 1) << 5); R = (st >> 1) * 16 + swz / 64; C = (st & 1) * 32 + (swz % 64) / 2; }
__host__ __device__ __forceinline__ int perm32(int rho) { const int n = rho >> 4, i = rho & 15; return 8 * (i >> 2) + 4 * n + (i & 3); }

struct Unit { int pm, pn; };
struct Gemm { const bf16_t* A; const bf16_t* Bt; int M, N, K; size_t a_tstep; };

struct StaticOrder {
    int nM, nN, nwg, G, c;
    __host__ __device__ void init(int M, int N, int G_, int c_) { nM = M / BM; nN = N / BM; nwg = nM * nN; G = G_; c = c_; }
    __host__ __device__ bool next(int i, Unit& u) const {
        const long L = (long)i * G + c; if (L >= nwg) return false;
        int wgid = (int)L; { const int q = nwg / NXCD, r = nwg % NXCD, xcd = wgid % NXCD, off = wgid / NXCD; wgid = (xcd < r ? xcd * (q + 1) : r * (q + 1) + (xcd - r) * q) + off; }
        const int nig = WGM * nN, gid = wgid / nig, fm = gid * WGM, gsz = (nM - fm) < WGM ? (nM - fm) : WGM;
        u.pm = fm + ((wgid % nig) % gsz); u.pn = (wgid % nig) / gsz; return true;
    }
    __device__ __forceinline__ void a_ready(const Unit&) const {}
    __device__ __forceinline__ void done(const Unit&) const {}
};
__device__ __forceinline__ unsigned cvt_pk_bf16(float lo, float hi) { unsigned r; asm volatile("v_cvt_pk_bf16_f32 %0, %1, %2" : "=v"(r) : "v"(lo), "v"(hi)); return r; }
typedef float f32x2 __attribute__((ext_vector_type(2)));
template <class Epi, class Sched, bool ALIGN_EPI = false, bool SP2 = false>
__device__ __forceinline__ void gemm_phase(PG8_LAS unsigned char* lds, const Gemm g, const Sched& S, const Epi& E, const int wid  ) {
    int lane; asm volatile("v_mbcnt_lo_u32_b32 %0, -1, 0\n\tv_mbcnt_hi_u32_b32 %0, -1, %0\n\ts_nop 1" : "=v"(lane));
    const int tid = wid * 64 + lane, wr = wid >> 2, wc = wid & 3, fr = lane & 15, fq = lane >> 4;
    const int K = g.K, nt = K / BK;
    unsigned voffA[2], voffB[2];
#pragma unroll
    for (int i = 0; i < 2; ++i) { int R, C; stage_rc(tid * 16 + i * 8192, R, C); const int Rb = Epi::PERM ? ((R & ~31) + perm32(R & 31)) : R;
        voffA[i] = (unsigned)(R * K + C) * 2u; voffB[i] = (unsigned)(Rb * K + C) * 2u; }
    const size_t kstep = (size_t)(BK * 2);
    const size_t hstep = (size_t)HALF * K * 2;
    const size_t tstep = 2 * hstep;
    const unsigned ldsw = (unsigned)wid * 1024u;
    const int aoff = lds_byte(wr * 64 + fr, fq * 8), boff = lds_byte(wc * 32 + fr, fq * 8);
#define PG8_SA(b, h) (((b) * 2 + (h)) * HTB)
#define PG8_SB(b, h) ((4 + (b) * 2 + (h)) * HTB)
#define PG8_STAGE(bufoff, gbase, voff) do { _Pragma("unroll") for (int _i = 0; _i < 2; ++_i) \
        __builtin_amdgcn_global_load_lds((const unsigned*)((const char*)(gbase) + (voff)[_i]), (PG8_LAS unsigned*)(lds + (bufoff) + ldsw + _i * 8192), 16, 0, 0); } while (0)
#define PG8_LDA(dst, b, h) do { _Pragma("unroll") for (int m = 0; m < 4; ++m) _Pragma("unroll") for (int k = 0; k < 2; ++k) dst[m][k] = *(const PG8_LAS bf16x8*)(lds + PG8_SA(b, h) + aoff + m * 2048 + k * 1024); } while (0)
#define PG8_LDB(dst, b, h) do { _Pragma("unroll") for (int n = 0; n < 2; ++n) _Pragma("unroll") for (int k = 0; k < 2; ++k) dst[n][k] = *(const PG8_LAS bf16x8*)(lds + PG8_SB(b, h) + boff + n * 2048 + k * 1024); } while (0)
#define PG8_MMA(ai, bj, At, Bt) do { __builtin_amdgcn_s_setprio(1); _Pragma("unroll") for (int m = 0; m < 4; ++m) _Pragma("unroll") for (int n = 0; n < 2; ++n) _Pragma("unroll") for (int k = 0; k < 2; ++k) \
        acc[ai][bj][m][n] = __builtin_amdgcn_mfma_f32_16x16x32_bf16(Bt[n][k], At[m][k], acc[ai][bj][m][n], 0, 0, 0); __builtin_amdgcn_s_setprio(0); } while (0)
#define PG8_WAIT_V(n) asm volatile("s_waitcnt vmcnt(" #n ")" ::: "memory")
#define PG8_WAIT_L(n) asm volatile("s_waitcnt lgkmcnt(" #n ")" ::: "memory")
#define PG8_BAR __builtin_amdgcn_s_barrier()
#define PG8_SCHED __builtin_amdgcn_sched_barrier(0)
    Unit cur, nxt; int ui = 0;
    if (!S.next(0, cur)) return;
    f32x4 acc[2][2][4][2];
#pragma unroll
    for (int a = 0; a < 2; ++a)
#pragma unroll
        for (int b = 0; b < 2; ++b)
#pragma unroll
            for (int m = 0; m < 4; ++m)
#pragma unroll
                for (int n = 0; n < 2; ++n) acc[a][b][m][n] = (f32x4){0.f, 0.f, 0.f, 0.f};
    bf16x8 At[4][2], B0[2][2], B1[2][2];
    const char* cA = (const char*)g.A + (size_t)cur.pm * g.a_tstep; const char* cB = (const char*)g.Bt + (size_t)cur.pn * tstep;
    S.a_ready(cur);
    if constexpr (SP2) {
        PG8_STAGE(PG8_SB(0, 0), cB, voffB); PG8_STAGE(PG8_SB(0, 1), cB + hstep, voffB); PG8_STAGE(PG8_SA(0, 0), cA, voffA); PG8_STAGE(PG8_SA(0, 1), cA + hstep, voffA);
        if (wr == 1) PG8_BAR;
        PG8_WAIT_V(2); PG8_BAR;
        PG8_STAGE(PG8_SB(1, 0), cB + kstep, voffB); PG8_STAGE(PG8_SA(1, 0), cA + kstep, voffA); PG8_STAGE(PG8_SB(1, 1), cB + hstep + kstep, voffB);
        PG8_WAIT_V(6); PG8_BAR;
    } else {
        PG8_STAGE(PG8_SB(0, 0), cB, voffB); PG8_STAGE(PG8_SA(0, 0), cA, voffA); PG8_STAGE(PG8_SB(0, 1), cB + hstep, voffB); PG8_STAGE(PG8_SA(0, 1), cA + hstep, voffA);
        if (wr == 1) PG8_BAR;
        PG8_WAIT_V(4); PG8_BAR;
        PG8_STAGE(PG8_SB(1, 0), cB + kstep, voffB); PG8_STAGE(PG8_SA(1, 0), cA + kstep, voffA); PG8_STAGE(PG8_SB(1, 1), cB + hstep + kstep, voffB);
        PG8_WAIT_V(6); PG8_BAR;
    }
    for (;;) {
        const bool has_next = S.next(ui + 1, nxt);
        const char* nA = has_next ? (const char*)g.A + (size_t)nxt.pm * g.a_tstep : cA; const char* nB = has_next ? (const char*)g.Bt + (size_t)nxt.pn * tstep : cB;
        for (int t = 0; t < nt; t += 2) {
            const bool last = (t == nt - 2);
            const char* a1 = cA + (size_t)(t + 1) * kstep;
            const char* a2 = last ? nA : cA + (size_t)(t + 2) * kstep; const char* b2 = last ? nB : cB + (size_t)(t + 2) * kstep;
            const char* a3 = a2 + kstep; const char* b3 = b2 + kstep;
            if (last && has_next) S.a_ready(nxt);
            if constexpr (SP2) {
            PG8_LDB(B0, 0, 0); PG8_LDB(B1, 0, 1); PG8_SCHED; PG8_LDA(At, 0, 0); PG8_STAGE(PG8_SA(1, 1), a1 + hstep, voffA);
            PG8_WAIT_V(8); PG8_WAIT_L(0); PG8_BAR; PG8_MMA(0, 0, At, B0); PG8_MMA(0, 1, At, B1); PG8_BAR; PG8_SCHED;
            PG8_LDA(At, 0, 1); PG8_STAGE(PG8_SB(0, 0), b2, voffB); PG8_STAGE(PG8_SB(0, 1), b2 + hstep, voffB); PG8_STAGE(PG8_SA(0, 0), a2, voffA);
            PG8_WAIT_V(8); PG8_WAIT_L(0); PG8_BAR; PG8_MMA(1, 0, At, B0); PG8_MMA(1, 1, At, B1); PG8_BAR; PG8_SCHED;
            PG8_LDB(B0, 1, 0); PG8_LDB(B1, 1, 1); PG8_SCHED; PG8_LDA(At, 1, 0); PG8_STAGE(PG8_SA(0, 1), a2 + hstep, voffA);
            PG8_WAIT_V(8); PG8_WAIT_L(0); PG8_BAR; PG8_MMA(0, 0, At, B0); PG8_MMA(0, 1, At, B1); PG8_BAR; PG8_SCHED;
            PG8_LDA(At, 1, 1); PG8_STAGE(PG8_SB(1, 0), b3, voffB); PG8_STAGE(PG8_SB(1, 1), b3 + hstep, voffB); PG8_STAGE(PG8_SA(1, 0), a3, voffA);
            PG8_WAIT_V(8); PG8_WAIT_L(0); PG8_BAR; PG8_MMA(1, 0, At, B0); PG8_MMA(1, 1, At, B1); PG8_BAR; PG8_SCHED;
            } else {
            PG8_LDB(B0, 0, 0); PG8_SCHED; PG8_LDA(At, 0, 0); PG8_STAGE(PG8_SA(1, 1), a1 + hstep, voffA);
            PG8_WAIT_L(8); PG8_BAR; PG8_WAIT_L(0); PG8_MMA(0, 0, At, B0); PG8_BAR; PG8_SCHED;
            PG8_LDB(B1, 0, 1); PG8_STAGE(PG8_SB(0, 0), b2, voffB);
            PG8_BAR; PG8_WAIT_L(0); PG8_MMA(0, 1, At, B1); PG8_BAR;
            PG8_LDA(At, 0, 1); PG8_STAGE(PG8_SA(0, 0), a2, voffA);
            PG8_BAR; PG8_WAIT_L(0); PG8_MMA(1, 0, At, B0); PG8_BAR; PG8_SCHED;
            PG8_STAGE(PG8_SB(0, 1), b2 + hstep, voffB);
            PG8_WAIT_V(6); PG8_BAR; PG8_MMA(1, 1, At, B1); PG8_BAR;
            PG8_LDB(B0, 1, 0); PG8_SCHED; PG8_LDA(At, 1, 0); PG8_STAGE(PG8_SA(0, 1), a2 + hstep, voffA);
            PG8_WAIT_L(8); PG8_BAR; PG8_WAIT_L(0); PG8_MMA(0, 0, At, B0); PG8_BAR; PG8_SCHED;
            PG8_LDB(B1, 1, 1); PG8_STAGE(PG8_SB(1, 0), b3, voffB);
            PG8_BAR; PG8_WAIT_L(0); PG8_MMA(0, 1, At, B1); PG8_BAR;
            PG8_LDA(At, 1, 1); PG8_STAGE(PG8_SA(1, 0), a3, voffA);
            PG8_BAR; PG8_WAIT_L(0); PG8_MMA(1, 0, At, B0); PG8_BAR; PG8_SCHED;
            PG8_STAGE(PG8_SB(1, 1), b3 + hstep, voffB);
            PG8_WAIT_V(6); PG8_BAR; PG8_MMA(1, 1, At, B1); PG8_BAR;
            }
        }
        if constexpr (ALIGN_EPI) { if (wr == 0) PG8_BAR; }
        if constexpr (!Epi::AFTER_DRAIN) { E(acc, cur, wr, wc, fr, fq); S.done(cur); }
        if (!has_next) break;
#pragma unroll
        for (int a = 0; a < 2; ++a)
#pragma unroll
            for (int b = 0; b < 2; ++b)
#pragma unroll
                for (int m = 0; m < 4; ++m)
#pragma unroll
                    for (int n = 0; n < 2; ++n) acc[a][b][m][n] = (f32x4){0.f, 0.f, 0.f, 0.f};
        cur = nxt; cA = nA; cB = nB; ++ui;
        if constexpr (ALIGN_EPI) { if (wr == 1) PG8_BAR; }
    }
    PG8_WAIT_V(0);
    if constexpr (!ALIGN_EPI) { if (wr == 0) PG8_BAR; }
    PG8_BAR;
    if constexpr (Epi::AFTER_DRAIN) { E.fused(acc, cur, wr, wc, fr, fq, lds, wid, lane); S.done(cur); }
#undef PG8_SA
#undef PG8_SB
#undef PG8_STAGE
#undef PG8_LDA
#undef PG8_LDB
#undef PG8_MMA
#undef PG8_WAIT_V
#undef PG8_WAIT_L
#undef PG8_BAR
#undef PG8_SCHED
}
}

#define LAS __attribute__((address_space(3)))
using pg8::bf16_t; using pg8::bf16x8; using pg8::f32x4; using pg8::u32x4; using pg8::cvt_pk_bf16;
typedef unsigned u32x2 __attribute__((ext_vector_type(2)));
typedef float f32x16 __attribute__((ext_vector_type(16)));

constexpr int S_ = 16384, D_ = 2048, DIN = 5200, ZLD = 5376, DFF = 5632;
constexpr int OFF_Q = 1024, OFF_K = 2048, OFF_V = 3072, OFF_QI = 4096, OFF_KI = 5120, OFF_WI = 5184;
constexpr float EPS_ = 1e-6f;
constexpr int UP_ROWS = 254;
constexpr int UP_TILES = 65;
constexpr size_t WS_WIN = 0;
constexpr size_t WS_WOUT = WS_WIN + (size_t)ZLD * D_ * 2;
constexpr size_t WS_WUP = WS_WOUT + (size_t)D_ * D_ * 2;
constexpr size_t WS_WDN = WS_WUP + (size_t)2 * DFF * D_ * 2;
constexpr size_t WS_PW = WS_WDN + (size_t)D_ * DFF * 2;
constexpr size_t WS_H = WS_PW + (size_t)4 * 256 * 256 * 2;
constexpr size_t WS_Z = WS_H + (size_t)(S_ + 128) * D_ * 2;
constexpr size_t WS_YMIX = WS_Z + (size_t)S_ * ZLD * 2;
constexpr size_t WS_DP = WS_YMIX + (size_t)S_ * D_ * 2;
constexpr size_t WS_SEL = WS_DP + (size_t)S_ * 1024 * 2;
constexpr size_t WS_KV8 = WS_SEL + (size_t)S_ * 256 * 4;
constexpr size_t WS_KI = WS_KV8 + (size_t)S_ * 2048;
constexpr size_t WS_BAR = WS_KI + (size_t)S_ * 64 * 2;
constexpr size_t WS_END = WS_BAR + 16384;
constexpr size_t WS_ACT = WS_Z;
static_assert((size_t)S_ * DFF * 2 <= (size_t)S_ * ZLD * 2 + (size_t)S_ * D_ * 2, "act overlay");
constexpr int LDS_XL = pg8::STAGE_BYTES;
constexpr int LDS_BARST = pg8::STAGE_BYTES + 8192;
constexpr int LDS_BYTES = pg8::STAGE_BYTES + 8192 + 256;

struct Params { const float* in[13]; float* out; unsigned char* ws; };

__device__ __forceinline__ float bf_lo(unsigned v) { return __uint_as_float(v << 16); }
__device__ __forceinline__ float bf_hi(unsigned v) { return __uint_as_float(v & 0xffff0000u); }
__device__ __forceinline__ float wave_sum(float v) {
#pragma unroll
    for (int o = 1; o < 64; o <<= 1) v += __shfl_xor(v, o);
    return v;
}
__device__ __forceinline__ float wave_max(float v) {
#pragma unroll
    for (int o = 1; o < 64; o <<= 1) v = fmaxf(v, __shfl_xor(v, o));
    return v;
}
template <int CTRL> __device__ __forceinline__ float dpp_f(float v) { return __int_as_float(__builtin_amdgcn_update_dpp(0, __float_as_int(v), CTRL, 0xF, 0xF, true)); }
__device__ __forceinline__ float red16(float v) { v += dpp_f<0xB1>(v); v += dpp_f<0x4E>(v); v += dpp_f<0x141>(v); v += dpp_f<0x140>(v); return v; }
__device__ __forceinline__ f32x4 ror1(f32x4 v) { f32x4 r; r.x = dpp_f<0x121>(v.x); r.y = dpp_f<0x121>(v.y); r.z = dpp_f<0x121>(v.z); r.w = dpp_f<0x121>(v.w); return r; }
__device__ __forceinline__ f32x4 ror2(f32x4 v) { f32x4 r; r.x = dpp_f<0x122>(v.x); r.y = dpp_f<0x122>(v.y); r.z = dpp_f<0x122>(v.z); r.w = dpp_f<0x122>(v.w); return r; }
__device__ __forceinline__ f32x4 sel4(bool c, f32x4 a, f32x4 b) { f32x4 r; r.x = c ? a.x : b.x; r.y = c ? a.y : b.y; r.z = c ? a.z : b.z; r.w = c ? a.w : b.w; return r; }
__device__ __forceinline__ float dot8(u32x4 a, u32x4 b) { float acc = 0.f;
    asm volatile("v_dot2c_f32_bf16 %0, %1, %5\n\tv_dot2c_f32_bf16 %0, %2, %6\n\tv_dot2c_f32_bf16 %0, %3, %7\n\tv_dot2c_f32_bf16 %0, %4, %8\n\ts_nop 2"
                 : "+v"(acc) : "v"(a.x), "v"(a.y), "v"(a.z), "v"(a.w), "v"(b.x), "v"(b.y), "v"(b.z), "v"(b.w));
    return acc; }
__device__ __forceinline__ int mbcnt64(unsigned long long m) { return __builtin_amdgcn_mbcnt_hi((unsigned)(m >> 32), __builtin_amdgcn_mbcnt_lo((unsigned)m, 0)); }
#define LDS_WAIT() asm volatile("s_waitcnt lgkmcnt(0)" ::: "memory")
__device__ __forceinline__ int lane_id() { int l; asm volatile("v_mbcnt_lo_u32_b32 %0, -1, 0\n\tv_mbcnt_hi_u32_b32 %0, -1, %0\n\ts_nop 1" : "=v"(l)); return l; }

__device__ __forceinline__ void transpose_item(const float* __restrict__ W, int N, int src_n0, int n_valid, bf16_t* __restrict__ WT, int Kd, int dst_row0, int k0,
                                               const float* __restrict__ scale, LAS float* scr, int lane) {
    const int c4 = (lane & 15) * 4, kr = lane >> 4;
#pragma unroll 4
    for (int i = 0; i < 16; ++i) { const int kk = 4 * i + kr;
        f32x4 v = {0.f, 0.f, 0.f, 0.f};
        if (c4 < n_valid) v = *(const f32x4*)(W + (size_t)(k0 + kk) * N + src_n0 + c4);
        LAS float* d = scr + kk * 65 + c4; d[0] = v.x; d[1] = v.y; d[2] = v.z; d[3] = v.w; }
    LDS_WAIT();
    const int c8 = lane & 7;
#pragma unroll
    for (int j = 0; j < 8; ++j) { const int n = (lane >> 3) + 8 * j; const LAS float* s = scr + (8 * c8) * 65 + n;
        const float sc = (scale != nullptr && n < n_valid) ? scale[src_n0 + n] : 1.f;
        u32x4 o; o.x = cvt_pk_bf16(s[0 * 65] * sc, s[1 * 65] * sc); o.y = cvt_pk_bf16(s[2 * 65] * sc, s[3 * 65] * sc); o.z = cvt_pk_bf16(s[4 * 65] * sc, s[5 * 65] * sc); o.w = cvt_pk_bf16(s[6 * 65] * sc, s[7 * 65] * sc);
        *(u32x4*)(WT + (size_t)(dst_row0 + n) * Kd + k0 + 8 * c8) = o; }
    LDS_WAIT();
}
__device__ __forceinline__ void rmsnorm_row(const float* __restrict__ xrow, const float* __restrict__ g, bf16_t* __restrict__ orow, int lane) {
    const f32x4* xr = (const f32x4*)xrow + lane; f32x4 v[8]; float s = 0.f;
#pragma unroll
    for (int j = 0; j < 8; ++j) { v[j] = xr[64 * j]; s += (v[j].x * v[j].x + v[j].y * v[j].y) + (v[j].z * v[j].z + v[j].w * v[j].w); }
    const float r = 1.f / sqrtf(wave_sum(s) * (1.f / D_) + EPS_);
    const f32x4* gr = (const f32x4*)g + lane; u32x2* o8 = (u32x2*)orow + lane;
#pragma unroll
    for (int j = 0; j < 8; ++j) { const f32x4 gg = gr[64 * j]; u32x2 o; o.x = cvt_pk_bf16(v[j].x * r * gg.x, v[j].y * r * gg.y); o.y = cvt_pk_bf16(v[j].z * r * gg.z, v[j].w * r * gg.w); o8[64 * j] = o; }
}

struct EpiStoreBf16 {
    static constexpr bool PERM = true, AFTER_DRAIN = false;
    bf16_t* O; int ldc; bf16_t* KI;
    __device__ __forceinline__ void operator()(const f32x4 (&acc)[2][2][4][2], const pg8::Unit& u, int wr, int wc, int fr, int fq) const {
        const int row0 = u.pm * 256 + wr * 64 + fr, col0 = u.pn * 256 + wc * 32 + 8 * fq;
#pragma unroll
        for (int ai = 0; ai < 2; ++ai)
#pragma unroll
            for (int m = 0; m < 4; ++m) { bf16_t* rowp = O + (size_t)(row0 + ai * 128 + m * 16) * ldc + col0;
#pragma unroll
                for (int bj = 0; bj < 2; ++bj) { const f32x4 v0 = acc[ai][bj][m][0], v1 = acc[ai][bj][m][1];
                    u32x4 o; o.x = cvt_pk_bf16(v0.x, v0.y); o.y = cvt_pk_bf16(v0.z, v0.w); o.z = cvt_pk_bf16(v1.x, v1.y); o.w = cvt_pk_bf16(v1.z, v1.w);
                    *(u32x4*)(rowp + bj * 128) = o;
                    if (bj == 0 && u.pn == 20 && wc < 2) { const int row = row0 + ai * 128 + m * 16; ((u32x4*)KI)[(size_t)(row >> 5) * 256 + (4 * wc + fq) * 32 + (row & 31)] = o; } }
                asm volatile("" ::: "memory"); }
    }
};
struct EpiPool {
    static constexpr bool PERM = true, AFTER_DRAIN = false;
    bf16_t* O;
    __device__ __forceinline__ void operator()(const f32x4 (&acc)[2][2][4][2], const pg8::Unit& u, int wr, int wc, int fr, int fq) const {
        const int g = u.pm >> 6, row0 = (u.pm & 63) * 256 + wr * 64 + fr, col0 = g * 256 + wc * 32 + 8 * fq;
#pragma unroll
        for (int ai = 0; ai < 2; ++ai)
#pragma unroll
            for (int m = 0; m < 4; ++m) { bf16_t* rowp = O + (size_t)(row0 + ai * 128 + m * 16) * D_ + col0;
#pragma unroll
                for (int bj = 0; bj < 2; ++bj) { const f32x4 v0 = acc[ai][bj][m][0], v1 = acc[ai][bj][m][1];
                    u32x4 o; o.x = cvt_pk_bf16(v0.x, v0.y); o.y = cvt_pk_bf16(v0.z, v0.w); o.z = cvt_pk_bf16(v1.x, v1.y); o.w = cvt_pk_bf16(v1.z, v1.w);
                    *(u32x4*)(rowp + bj * 128) = o; } }
    }
};
struct PoolOrder {
    int G, c;
    __device__ __forceinline__ bool next(int i, pg8::Unit& u) const { const int L = i * G + c; if (L >= 256) return false; u.pm = L; u.pn = L >> 6; return true; }
    __device__ __forceinline__ void a_ready(const pg8::Unit&) const {}
    __device__ __forceinline__ void done(const pg8::Unit&) const {}
};
struct EpiResid {
    static constexpr bool PERM = false, AFTER_DRAIN = false;
    const float* src; float* dst;
    __device__ __forceinline__ void operator()(const f32x4 (&acc)[2][2][4][2], const pg8::Unit& u, int wr, int wc, int fr, int fq) const {
        const int row0 = u.pm * 256 + wr * 64 + fr, col0 = u.pn * 256 + wc * 32 + 4 * fq;
#pragma unroll
        for (int ai = 0; ai < 2; ++ai)
#pragma unroll
            for (int m = 0; m < 4; ++m) { const size_t off = (size_t)(row0 + ai * 128 + m * 16) * D_ + col0;
#pragma unroll
                for (int bj = 0; bj < 2; ++bj)
#pragma unroll
                    for (int n = 0; n < 2; ++n) { const f32x4 s = *(const f32x4*)(src + off + bj * 128 + n * 16); *(f32x4*)(dst + off + bj * 128 + n * 16) = s + acc[ai][bj][m][n]; }
                asm volatile("" ::: "memory"); }
    }
};
struct EpiUp {
    static constexpr bool PERM = true, AFTER_DRAIN = false;
    bf16_t* ACT; const float* cw; const float* cb; LAS f32x4* xl;
    __device__ __forceinline__ void operator()(const f32x4 (&acc)[2][2][4][2], const pg8::Unit& u, int wr, int wc, int fr, int fq) const {
        if (fr >= 14) {
#pragma unroll
            for (int ai = 0; ai < 2; ++ai)
#pragma unroll
                for (int bj = 0; bj < 2; ++bj)
#pragma unroll
                    for (int n = 0; n < 2; ++n) xl[((((wr * 4 + wc) * 2 + ai) * 2 + bj) * 2 + n) * 8 + fq * 2 + (fr - 14)] = acc[ai][bj][3][n];
        }
        LDS_WAIT();
        __builtin_amdgcn_s_barrier();
        asm volatile("" ::: "memory");
        const int t0 = UP_ROWS * u.pm - 2 + 64 * wr + fr, r0 = 64 * wr + fr;
        const int chb = 128 * u.pn + 32 * wc + 8 * fq;
        const int swr = wr ^ 1;
#pragma unroll
        for (int n = 0; n < 2; ++n) {
            const int ch = chb + 4 * n;
            f32x4 w0[2], w1[2], w2[2], bb[2];
#pragma unroll
            for (int bj = 0; bj < 2; ++bj) { const int c = ch + bj * DFF; w0[bj] = *(const f32x4*)(cw + c); w1[bj] = *(const f32x4*)(cw + 2 * DFF + c); w2[bj] = *(const f32x4*)(cw + 4 * DFF + c); bb[bj] = *(const f32x4*)(cb + c); }
#pragma unroll
            for (int ai = 0; ai < 2; ++ai) {
                const int sai = (wr == 1) ? ai : 0;
                f32x4 h14[2], h15[2], pr1[2], pr2[2];
#pragma unroll
                for (int bj = 0; bj < 2; ++bj) { const int base = ((((swr * 4 + wc) * 2 + sai) * 2 + bj) * 2 + n) * 8 + fq * 2; h14[bj] = xl[base]; h15[bj] = xl[base + 1]; pr1[bj] = h15[bj]; pr2[bj] = (fr == 0) ? h14[bj] : h15[bj]; }
#pragma unroll
                for (int m = 0; m < 4; ++m) {
                    f32x4 cc[2];
#pragma unroll
                    for (int bj = 0; bj < 2; ++bj) { const f32x4 X = acc[ai][bj][m][n], R1 = ror1(X), R2 = ror2(X);
                        const f32x4 p1 = sel4(fr >= 1, R1, pr1[bj]), p2 = sel4(fr >= 2, R2, pr2[bj]);
                        pr1[bj] = R1; pr2[bj] = R2;
                        cc[bj] = bb[bj] + w0[bj] * p2 + w1[bj] * p1 + w2[bj] * X; }
                    const f32x4 gt = cc[0], vl = cc[1]; f32x4 o;
                    o.x = gt.x * __builtin_amdgcn_rcpf(1.f + __expf(-gt.x)) * vl.x; o.y = gt.y * __builtin_amdgcn_rcpf(1.f + __expf(-gt.y)) * vl.y;
                    o.z = gt.z * __builtin_amdgcn_rcpf(1.f + __expf(-gt.z)) * vl.z; o.w = gt.w * __builtin_amdgcn_rcpf(1.f + __expf(-gt.w)) * vl.w;
                    const int t = t0 + 128 * ai + 16 * m, r = r0 + 128 * ai + 16 * m;
                    if (r >= 2 && t < S_) { u32x2 ov; ov.x = cvt_pk_bf16(o.x, o.y); ov.y = cvt_pk_bf16(o.z, o.w); *(u32x2*)(ACT + (size_t)t * DFF + ch) = ov; }
                }
            }
        }
    }
};

__device__ __forceinline__ unsigned f2ord(float f) { const unsigned u = __float_as_uint(f); return u ^ ((u >> 31) ? 0xFFFFFFFFu : 0x80000000u); }
__device__ __forceinline__ unsigned ord2bits(unsigned k) { return (k & 0x80000000u) ? (k ^ 0x80000000u) : ~k; }
__device__ __forceinline__ int topk_compact(LAS u32x2* buf, int cnt, float& tau) {
    const int lane = lane_id();
    LDS_WAIT();
    unsigned key[8], idx[8];
    unsigned kmin = 0xFFFFFFFFu, kmax = 0u;
#pragma unroll
    for (int j = 0; j < 8; ++j) { const int e = j * 64 + lane; const u32x2 v = buf[e]; const bool ok = e < cnt; const unsigned k = f2ord(__uint_as_float(v.x)); key[j] = ok ? k : 0u; idx[j] = v.y;
        kmin = (ok && k < kmin) ? k : kmin; kmax = (ok && k > kmax) ? k : kmax; }
#pragma unroll
    for (int o = 1; o < 64; o <<= 1) { const unsigned a = (unsigned)__shfl_xor((int)kmin, o), b = (unsigned)__shfl_xor((int)kmax, o); kmin = a < kmin ? a : kmin; kmax = b > kmax ? b : kmax; }
    const unsigned diff = (unsigned)__builtin_amdgcn_readfirstlane((int)(kmin ^ kmax));
    int bit = diff ? (31 - __builtin_clz(diff)) : -1;
    unsigned T = (bit >= 0) ? (unsigned)__builtin_amdgcn_readfirstlane((int)kmin) & ~((2u << bit) - 1u) : (unsigned)__builtin_amdgcn_readfirstlane((int)kmin);
    int cT = cnt;
#pragma unroll 1
    for (; bit >= 0 && cT != 256; --bit) {
        const unsigned cand = T | (1u << bit); int c = 0;
#pragma unroll
        for (int j = 0; j < 8; ++j) c += __builtin_popcountll(__builtin_amdgcn_ballot_w64(key[j] >= cand));
        if (c >= 256) { T = cand; cT = c; }
    }
    int base = 0;
    if (cT == 256) {
#pragma unroll
        for (int j = 0; j < 8; ++j) { const bool g = key[j] >= T; const unsigned long long mk = __builtin_amdgcn_ballot_w64(g); const int pos = base + mbcnt64(mk);
            if (g) { u32x2 o; o.x = ord2bits(key[j]); o.y = idx[j]; buf[pos] = o; } base += __builtin_popcountll(mk); }
    } else {
#pragma unroll
        for (int j = 0; j < 8; ++j) { const bool g = key[j] > T; const unsigned long long mk = __builtin_amdgcn_ballot_w64(g); const int pos = base + mbcnt64(mk);
            if (g) { u32x2 o; o.x = ord2bits(key[j]); o.y = idx[j]; buf[pos] = o; } base += __builtin_popcountll(mk); }
#pragma unroll
        for (int j = 0; j < 8; ++j) { const bool g = key[j] == T; const unsigned long long mk = __builtin_amdgcn_ballot_w64(g); const int pos = base + mbcnt64(mk);
            if (g && pos < 256) { u32x2 o; o.x = ord2bits(key[j]); o.y = idx[j]; buf[pos] = o; } base += __builtin_popcountll(mk); }
    }
    tau = __uint_as_float(ord2bits(cT == 256 ? T - 1u : T));
    LDS_WAIT();
    return base < 256 ? base : 256;
}
__device__ __forceinline__ void indexer_pair(const bf16_t* __restrict__ Z, int* __restrict__ SEL, int pair, LAS u32x2* wbuf  ) {
    const int lane = lane_id(), half = lane >> 5, r = lane & 31;
    const int tA = 2 * pair, tmine = tA + half;
    bf16x8 Af[4];
    { const int aq = tA + ((r >> 2) & 1), ah = (r >> 3) * 4 + (r & 3);
      const bf16_t* ap = Z + (size_t)aq * ZLD + OFF_QI + ah * 64 + half * 8;
#pragma unroll
      for (int kk = 0; kk < 4; ++kk) Af[kk] = *(const bf16x8*)(ap + kk * 16); }
    float wq[16];
    { const u32x4* wp = (const u32x4*)(Z + (size_t)tmine * ZLD + OFF_WI); const u32x4 a = wp[0], b = wp[1];
      wq[0] = bf_lo(a.x); wq[1] = bf_hi(a.x); wq[2] = bf_lo(a.y); wq[3] = bf_hi(a.y); wq[4] = bf_lo(a.z); wq[5] = bf_hi(a.z); wq[6] = bf_lo(a.w); wq[7] = bf_hi(a.w);
      wq[8] = bf_lo(b.x); wq[9] = bf_hi(b.x); wq[10] = bf_lo(b.y); wq[11] = bf_hi(b.y); wq[12] = bf_lo(b.z); wq[13] = bf_hi(b.z); wq[14] = bf_lo(b.w); wq[15] = bf_hi(b.w);
#pragma unroll
      for (int i = 0; i < 16; ++i) wq[i] *= 0.03125f; }
    const int nsteps = (tA + 2 + 31) >> 5;
    float tau = -__builtin_inff(); int cntA = 0, cntB = 0;
    const bf16_t* bp = Z + (size_t)r * ZLD + OFF_KI + half * 8;
    bf16x8 Bn[4];
#pragma unroll
    for (int kk = 0; kk < 4; ++kk) Bn[kk] = *(const bf16x8*)(bp + kk * 16);
#pragma unroll 1
    for (int step = 0; step < nsteps; ++step) {
        bf16x8 Bc[4];
#pragma unroll
        for (int kk = 0; kk < 4; ++kk) Bc[kk] = Bn[kk];
        if (step + 1 < nsteps) { const bf16_t* np = bp + (size_t)(step + 1) * 32 * ZLD;
#pragma unroll
            for (int kk = 0; kk < 4; ++kk) Bn[kk] = *(const bf16x8*)(np + kk * 16); }
        f32x16 acc = {0.f, 0.f, 0.f, 0.f, 0.f, 0.f, 0.f, 0.f, 0.f, 0.f, 0.f, 0.f, 0.f, 0.f, 0.f, 0.f};
#pragma unroll
        for (int kk = 0; kk < 4; ++kk) acc = __builtin_amdgcn_mfma_f32_32x32x16_bf16(Af[kk], Bc[kk], acc, 0, 0, 0);
        float sc = 0.f;
#pragma unroll
        for (int i = 0; i < 16; ++i) sc = fmaf(wq[i], fmaxf(acc[i], 0.f), sc);
        const int key = step * 32 + r;
        const bool pass = (key <= tmine) && (sc > tau);
        const unsigned long long mk = __builtin_amdgcn_ballot_w64(pass);
        if (mk != 0ull) {
            const unsigned lo = (unsigned)mk, hi = (unsigned)(mk >> 32);
            const int pre = half ? __builtin_amdgcn_mbcnt_hi(hi, 0) : __builtin_amdgcn_mbcnt_lo(lo, 0);
            const int base = half ? cntB : cntA;
            if (pass) { u32x2 o; o.x = __float_as_uint(sc); o.y = (unsigned)key; wbuf[half * 512 + base + pre] = o; }
            cntA += __builtin_popcount(lo); cntB += __builtin_popcount(hi);
            if (cntA > 480) { float nt; cntA = topk_compact(wbuf, cntA, nt); tau = half ? tau : nt; }
            if (cntB > 480) { float nt; cntB = topk_compact(wbuf + 512, cntB, nt); tau = half ? nt : tau; }
        }
    }
    if (cntA > 256) { float nt; cntA = topk_compact(wbuf, cntA, nt); }
    if (cntB > 256) { float nt; cntB = topk_compact(wbuf + 512, cntB, nt); }
    LDS_WAIT();
#pragma unroll
    for (int jj = 0; jj < 4; ++jj) { const int e = lane + 64 * jj;
        if (e < cntA) SEL[(size_t)tA * 256 + e] = (int)wbuf[e].y;
        if (e < cntB) SEL[(size_t)(tA + 1) * 256 + e] = (int)wbuf[512 + e].y; }
    LDS_WAIT();
}

__device__ __forceinline__ void indexer_block16(const bf16_t* __restrict__ Z, const bf16_t* __restrict__ KI, int* __restrict__ SEL, int qb, LAS unsigned char* lds, int wave) {
    const int lane = lane_id(), tid = wave * 64 + lane, half = lane >> 5, r = lane & 31;
    LAS u32x2* wbuf = (LAS u32x2*)lds + wave * 1024;
    LAS unsigned char* tiles = lds + 65536;
    LAS int* flags = (LAS int*)(lds + 65536 + 32768);
    const int tA = qb * 16 + wave * 2, tmine = tA + half;
    bf16x8 Af[4];
    { const int aq = tA + ((r >> 2) & 1), ah = (r >> 3) * 4 + (r & 3);
      const bf16_t* ap = Z + (size_t)aq * ZLD + OFF_QI + ah * 64 + half * 8;
#pragma unroll
      for (int kk = 0; kk < 4; ++kk) Af[kk] = *(const bf16x8*)(ap + kk * 16); }
    float wq[16];
    { const u32x4* wp = (const u32x4*)(Z + (size_t)tmine * ZLD + OFF_WI); const u32x4 a = wp[0], b = wp[1];
      wq[0] = bf_lo(a.x); wq[1] = bf_hi(a.x); wq[2] = bf_lo(a.y); wq[3] = bf_hi(a.y); wq[4] = bf_lo(a.z); wq[5] = bf_hi(a.z); wq[6] = bf_lo(a.w); wq[7] = bf_hi(a.w);
      wq[8] = bf_lo(b.x); wq[9] = bf_hi(b.x); wq[10] = bf_lo(b.y); wq[11] = bf_hi(b.y); wq[12] = bf_lo(b.z); wq[13] = bf_hi(b.z); wq[14] = bf_lo(b.w); wq[15] = bf_hi(b.w);
#pragma unroll
      for (int i = 0; i < 16; ++i) wq[i] *= 0.03125f; }
    const int ntiles = (qb * 16 + 16 + 127) >> 7;
    float tau = -__builtin_inff(); int cntA = 0, cntB = 0;
    const u32x4* gsrc = (const u32x4*)KI + tid;
    { const u32x4 g0 = gsrc[0], g1 = gsrc[512]; *(LAS u32x4*)(tiles + tid * 16) = g0; *(LAS u32x4*)(tiles + 8192 + tid * 16) = g1; }
    __syncthreads();
#pragma unroll 1
    for (int i = 0; i < ntiles; ++i) {
        u32x4 g0 = {0u, 0u, 0u, 0u}, g1 = {0u, 0u, 0u, 0u};
        const bool more = (i + 1 < ntiles);
        if (more) { g0 = gsrc[(size_t)(i + 1) * 1024]; g1 = gsrc[(size_t)(i + 1) * 1024 + 512]; }
        const LAS unsigned char* tb = tiles + (i & 1) * 16384 + lane * 16;
        float sc[4];
#pragma unroll
        for (int st = 0; st < 4; ++st) {
            bf16x8 Bc[4];
#pragma unroll
            for (int kk = 0; kk < 4; ++kk) Bc[kk] = *(const LAS bf16x8*)(tb + (st * 4 + kk) * 1024);
            f32x16 acc = {0.f, 0.f, 0.f, 0.f, 0.f, 0.f, 0.f, 0.f, 0.f, 0.f, 0.f, 0.f, 0.f, 0.f, 0.f, 0.f};
#pragma unroll
            for (int kk = 0; kk < 4; ++kk) acc = __builtin_amdgcn_mfma_f32_32x32x16_bf16(Af[kk], Bc[kk], acc, 0, 0, 0);
            float s0 = 0.f, s1 = 0.f;
#pragma unroll
            for (int h = 0; h < 16; h += 2) { const int b0 = __float_as_int(acc[h]), b1 = __float_as_int(acc[h + 1]);
                s0 = fmaf(wq[h], __int_as_float(b0 > 0 ? b0 : 0), s0); s1 = fmaf(wq[h + 1], __int_as_float(b1 > 0 ? b1 : 0), s1); }
            sc[st] = s0 + s1;
#ifdef DUP_SCORE
            { f32x16 acc2 = {0.f, 0.f, 0.f, 0.f, 0.f, 0.f, 0.f, 0.f, 0.f, 0.f, 0.f, 0.f, 0.f, 0.f, 0.f, 0.f};
#pragma unroll
              for (int kk = 0; kk < 4; ++kk) acc2 = __builtin_amdgcn_mfma_f32_32x32x16_bf16(Af[kk], Bc[3 - kk], acc2, 0, 0, 0);
              float t0 = 0.f, t1 = 0.f;
#pragma unroll
              for (int h = 0; h < 16; h += 2) { const int b0 = __float_as_int(acc2[h]), b1 = __float_as_int(acc2[h + 1]);
                  t0 = fmaf(wq[h], __int_as_float(b0 > 0 ? b0 : 0), t0); t1 = fmaf(wq[h + 1], __int_as_float(b1 > 0 ? b1 : 0), t1); }
              asm volatile("" :: "v"(t0 + t1)); }
#endif
        }
#pragma unroll
        for (int st = 0; st < 4; ++st) {
            const int key = i * 128 + st * 32 + r;
            const bool pass = (key <= tmine) && (sc[st] > tau);
            const unsigned long long mk = __builtin_amdgcn_ballot_w64(pass);
            if (mk != 0ull) {
                const unsigned lo = (unsigned)mk, hi = (unsigned)(mk >> 32);
                const int pre = half ? __builtin_amdgcn_mbcnt_hi(hi, 0) : __builtin_amdgcn_mbcnt_lo(lo, 0);
                const int base = half ? cntB : cntA;
                if (pass) { u32x2 o; o.x = __float_as_uint(sc[st]); o.y = (unsigned)key; wbuf[half * 512 + base + pre] = o; }
                cntA += __builtin_popcount(lo); cntB += __builtin_popcount(hi);
            }
        }
        if (more) { LAS unsigned char* nb = tiles + ((i + 1) & 1) * 16384; *(LAS u32x4*)(nb + tid * 16) = g0; *(LAS u32x4*)(nb + 8192 + tid * 16) = g1; }
        if (lane == 0) flags[(i & 1) * 8 + wave] = (cntA > 384 || cntB > 384) ? 1 : 0;
        __syncthreads();
        const int vote = flags[(i & 1) * 8 + (lane & 7)];
        if (__builtin_amdgcn_ballot_w64(vote != 0) != 0ull) {
            if (cntA > 256) { float nt; cntA = topk_compact(wbuf, cntA, nt); tau = half ? tau : nt; }
            if (cntB > 256) { float nt; cntB = topk_compact(wbuf + 512, cntB, nt); tau = half ? nt : tau; }
#ifdef DUP_COMPACT
            if (cntA >= 256) { float nt; cntA = topk_compact(wbuf, cntA, nt); tau = half ? tau : nt; }
            if (cntB >= 256) { float nt; cntB = topk_compact(wbuf + 512, cntB, nt); tau = half ? nt : tau; }
#endif
        }
    }
    if (cntA > 256) { float nt; cntA = topk_compact(wbuf, cntA, nt); }
    if (cntB > 256) { float nt; cntB = topk_compact(wbuf + 512, cntB, nt); }
    LDS_WAIT();
#pragma unroll
    for (int jj = 0; jj < 4; ++jj) { const int e = lane + 64 * jj;
        if (e < cntA) SEL[(size_t)tA * 256 + e] = (int)wbuf[e].y;
        if (e < cntB) SEL[(size_t)(tA + 1) * 256 + e] = (int)wbuf[512 + e].y; }
    __syncthreads();
}

__device__ __forceinline__ void attn_query(const bf16_t* __restrict__ Z, const int* __restrict__ SEL, bf16_t* __restrict__ YMIX, int t, LAS float* sbuf  ) {
    const int lane = lane_id(), hq = lane >> 4;
    const int nsel = (t + 1 < 256) ? (t + 1) : 256;
    int iv[4];
#pragma unroll
    for (int jj = 0; jj < 4; ++jj) { const int e = lane + 64 * jj; iv[jj] = (e < nsel) ? SEL[(size_t)t * 256 + e] : 0; }
    const bf16_t* qp = Z + (size_t)t * ZLD + OFF_Q + lane * 8;
    const u32x4 qa = *(const u32x4*)qp, qb = *(const u32x4*)(qp + 512);
#pragma unroll
    for (int jj = 0; jj < 4; ++jj) {
        if (jj * 64 < nsel) {
#pragma unroll 1
            for (int l0 = 0; l0 < 64; l0 += 8) {
                const int j0 = jj * 64 + l0; if (j0 >= nsel) break;
                u32x4 ka[8], kb[8];
#pragma unroll
                for (int u = 0; u < 8; ++u) { const int si = __builtin_amdgcn_readlane(iv[jj], l0 + u); const bf16_t* kp = Z + (size_t)si * ZLD + OFF_K + lane * 8; ka[u] = *(const u32x4*)kp; kb[u] = *(const u32x4*)(kp + 512); }
#pragma unroll
                for (int u = 0; u < 8; ++u) { float da = dot8(qa, ka[u]), db = dot8(qb, kb[u]);
                    da = red16(da); db = red16(db);
                    if ((lane & 15) == 0) { sbuf[hq * 256 + j0 + u] = da; sbuf[(4 + hq) * 256 + j0 + u] = db; } }
            }
        }
    }
    LDS_WAIT();
#pragma unroll 1
    for (int h = 0; h < 8; ++h) {
        float sv[4]; float mx = -__builtin_inff();
#pragma unroll
        for (int jj = 0; jj < 4; ++jj) { const int j = lane + 64 * jj; const float s = sbuf[h * 256 + j]; sv[jj] = (j < nsel) ? s : -__builtin_inff(); mx = fmaxf(mx, sv[jj]); }
        mx = wave_max(mx); float sm = 0.f;
#pragma unroll
        for (int jj = 0; jj < 4; ++jj) { const int j = lane + 64 * jj; sv[jj] = (j < nsel) ? __expf(sv[jj] - mx) : 0.f; sm += sv[jj]; }
        sm = wave_sum(sm); const float inv = 1.f / sm;
#pragma unroll
        for (int jj = 0; jj < 4; ++jj) sbuf[h * 256 + lane + 64 * jj] = sv[jj] * inv;
    }
    LDS_WAIT();
    float oa[8], ob[8];
#pragma unroll
    for (int i = 0; i < 8; ++i) { oa[i] = 0.f; ob[i] = 0.f; }
#pragma unroll
    for (int jj = 0; jj < 4; ++jj) {
        if (jj * 64 < nsel) {
#pragma unroll 1
            for (int l0 = 0; l0 < 64; l0 += 8) {
                const int j0 = jj * 64 + l0; if (j0 >= nsel) break;
                u32x4 va[8], vb[8];
#pragma unroll
                for (int u = 0; u < 8; ++u) { const int si = __builtin_amdgcn_readlane(iv[jj], l0 + u); const bf16_t* vp = Z + (size_t)si * ZLD + OFF_V + lane * 8; va[u] = *(const u32x4*)vp; vb[u] = *(const u32x4*)(vp + 512); }
                const LAS f32x4* pa4 = (const LAS f32x4*)(sbuf + hq * 256 + j0); const LAS f32x4* pb4 = (const LAS f32x4*)(sbuf + (4 + hq) * 256 + j0);
                const f32x4 pa0 = pa4[0], pa1 = pa4[1], pb0 = pb4[0], pb1 = pb4[1];
                const float pa[8] = {pa0.x, pa0.y, pa0.z, pa0.w, pa1.x, pa1.y, pa1.z, pa1.w}, pb[8] = {pb0.x, pb0.y, pb0.z, pb0.w, pb1.x, pb1.y, pb1.z, pb1.w};
#pragma unroll
                for (int u = 0; u < 8; ++u) {
                    oa[0] = fmaf(pa[u], bf_lo(va[u].x), oa[0]); oa[1] = fmaf(pa[u], bf_hi(va[u].x), oa[1]); oa[2] = fmaf(pa[u], bf_lo(va[u].y), oa[2]); oa[3] = fmaf(pa[u], bf_hi(va[u].y), oa[3]);
                    oa[4] = fmaf(pa[u], bf_lo(va[u].z), oa[4]); oa[5] = fmaf(pa[u], bf_hi(va[u].z), oa[5]); oa[6] = fmaf(pa[u], bf_lo(va[u].w), oa[6]); oa[7] = fmaf(pa[u], bf_hi(va[u].w), oa[7]);
                    ob[0] = fmaf(pb[u], bf_lo(vb[u].x), ob[0]); ob[1] = fmaf(pb[u], bf_hi(vb[u].x), ob[1]); ob[2] = fmaf(pb[u], bf_lo(vb[u].y), ob[2]); ob[3] = fmaf(pb[u], bf_hi(vb[u].y), ob[3]);
                    ob[4] = fmaf(pb[u], bf_lo(vb[u].z), ob[4]); ob[5] = fmaf(pb[u], bf_hi(vb[u].z), ob[5]); ob[6] = fmaf(pb[u], bf_lo(vb[u].w), ob[6]); ob[7] = fmaf(pb[u], bf_hi(vb[u].w), ob[7]);
                }
            }
        }
    }
    u32x4 o0, o1;
    o0.x = cvt_pk_bf16(oa[0], oa[1]); o0.y = cvt_pk_bf16(oa[2], oa[3]); o0.z = cvt_pk_bf16(oa[4], oa[5]); o0.w = cvt_pk_bf16(oa[6], oa[7]);
    o1.x = cvt_pk_bf16(ob[0], ob[1]); o1.y = cvt_pk_bf16(ob[2], ob[3]); o1.z = cvt_pk_bf16(ob[4], ob[5]); o1.w = cvt_pk_bf16(ob[6], ob[7]);
    bf16_t* yp = YMIX + (size_t)t * D_ + 1024 + lane * 8;
    *(u32x4*)yp = o0; *(u32x4*)(yp + 512) = o1;
    LDS_WAIT();
}


typedef float f32x2v __attribute__((ext_vector_type(2)));
__device__ __forceinline__ float red8(float v) { v += dpp_f<0xB1>(v); v += dpp_f<0x4E>(v); v += dpp_f<0x141>(v); return v; }
__device__ __forceinline__ void kv8_issue(u32x4 (&buf)[8], const unsigned char* __restrict__ base  , unsigned voff  , const int (&iv)[4], int b) {
    const int jj = b >> 3, l0 = (b & 7) * 8;
    const int ivb = (jj == 0) ? iv[0] : (jj == 1) ? iv[1] : (jj == 2) ? iv[2] : iv[3];
#pragma unroll
    for (int u = 0; u < 8; ++u) { const int si = __builtin_amdgcn_readlane(ivb, l0 + u); buf[u] = *(const u32x4*)(base + (size_t)si * 2048 + voff); }
}
__device__ __forceinline__ void kv8_qk(const u32x4 (&buf)[8], const f32x2v (&q2)[8], LAS float* srow, int b, int lane) {
#pragma unroll
    for (int u = 0; u < 8; ++u) {
        const u32x4 k = buf[u];
        f32x2v s0 = q2[0] * __builtin_amdgcn_cvt_pk_f32_fp8(k.x, false), s1 = q2[1] * __builtin_amdgcn_cvt_pk_f32_fp8(k.x, true);
        s0 = __builtin_elementwise_fma(q2[2], __builtin_amdgcn_cvt_pk_f32_fp8(k.y, false), s0); s1 = __builtin_elementwise_fma(q2[3], __builtin_amdgcn_cvt_pk_f32_fp8(k.y, true), s1);
        s0 = __builtin_elementwise_fma(q2[4], __builtin_amdgcn_cvt_pk_f32_fp8(k.z, false), s0); s1 = __builtin_elementwise_fma(q2[5], __builtin_amdgcn_cvt_pk_f32_fp8(k.z, true), s1);
        s0 = __builtin_elementwise_fma(q2[6], __builtin_amdgcn_cvt_pk_f32_fp8(k.w, false), s0); s1 = __builtin_elementwise_fma(q2[7], __builtin_amdgcn_cvt_pk_f32_fp8(k.w, true), s1);
        const f32x2v t = s0 + s1;
        const float s = red8(t.x + t.y);
        if ((lane & 7) == 0) srow[b * 8 + u] = s;
    }
}
__device__ __forceinline__ void kv8_pv(const u32x4 (&buf)[8], f32x2v (&o2)[8], const LAS float* srow, int b) {
    const LAS f32x4* p4 = (const LAS f32x4*)(srow + b * 8);
    const f32x4 p0 = p4[0], p1 = p4[1];
    const float p[8] = {p0.x, p0.y, p0.z, p0.w, p1.x, p1.y, p1.z, p1.w};
#pragma unroll
    for (int u = 0; u < 8; ++u) {
        const u32x4 v = buf[u]; const f32x2v pp = {p[u], p[u]};
        o2[0] = __builtin_elementwise_fma(pp, __builtin_amdgcn_cvt_pk_f32_fp8(v.x, false), o2[0]); o2[1] = __builtin_elementwise_fma(pp, __builtin_amdgcn_cvt_pk_f32_fp8(v.x, true), o2[1]);
        o2[2] = __builtin_elementwise_fma(pp, __builtin_amdgcn_cvt_pk_f32_fp8(v.y, false), o2[2]); o2[3] = __builtin_elementwise_fma(pp, __builtin_amdgcn_cvt_pk_f32_fp8(v.y, true), o2[3]);
        o2[4] = __builtin_elementwise_fma(pp, __builtin_amdgcn_cvt_pk_f32_fp8(v.z, false), o2[4]); o2[5] = __builtin_elementwise_fma(pp, __builtin_amdgcn_cvt_pk_f32_fp8(v.z, true), o2[5]);
        o2[6] = __builtin_elementwise_fma(pp, __builtin_amdgcn_cvt_pk_f32_fp8(v.w, false), o2[6]); o2[7] = __builtin_elementwise_fma(pp, __builtin_amdgcn_cvt_pk_f32_fp8(v.w, true), o2[7]);
    }
}
__device__ __forceinline__ void attn_query8(const unsigned char* __restrict__ KV8, const bf16_t* __restrict__ Z, const int* __restrict__ SEL, bf16_t* __restrict__ YMIX, int t, LAS float* sbuf  ) {
    const int lane = lane_id(), hd = lane >> 3;
    const int nsel = (t + 1 < 256) ? (t + 1) : 256, nb = (nsel + 7) >> 3;
    int iv[4];
#pragma unroll
    for (int jj = 0; jj < 4; ++jj) { const int e = lane + 64 * jj; iv[jj] = (e < nsel) ? SEL[(size_t)t * 256 + e] : 0; }
    f32x2v qf[8];
    { const u32x4* qp = (const u32x4*)(Z + (size_t)t * ZLD + OFF_Q + lane * 16); const u32x4 a = qp[0], b = qp[1];
      qf[0] = (f32x2v){bf_lo(a.x), bf_hi(a.x)}; qf[1] = (f32x2v){bf_lo(a.y), bf_hi(a.y)}; qf[2] = (f32x2v){bf_lo(a.z), bf_hi(a.z)}; qf[3] = (f32x2v){bf_lo(a.w), bf_hi(a.w)};
      qf[4] = (f32x2v){bf_lo(b.x), bf_hi(b.x)}; qf[5] = (f32x2v){bf_lo(b.y), bf_hi(b.y)}; qf[6] = (f32x2v){bf_lo(b.z), bf_hi(b.z)}; qf[7] = (f32x2v){bf_lo(b.w), bf_hi(b.w)}; }
    const unsigned kvo = (unsigned)lane * 16u, vvo = 1024u + (unsigned)lane * 16u;
    LAS float* srow = sbuf + hd * 256;
    u32x4 A[8], B[8], C[8];
    const int lb = nb - 1;
#define CLAMPB(x) ((x) < lb ? (x) : lb)
    kv8_issue(A, KV8, kvo, iv, 0);
    kv8_issue(B, KV8, kvo, iv, CLAMPB(1));
#pragma unroll 1
    for (int b = 0; b < nb; b += 3) {
        kv8_issue(C, KV8, kvo, iv, CLAMPB(b + 2));
        kv8_qk(A, qf, srow, b, lane);
        kv8_issue(A, KV8, kvo, iv, CLAMPB(b + 3));
        if (b + 1 < nb) kv8_qk(B, qf, srow, b + 1, lane);
        kv8_issue(B, KV8, kvo, iv, CLAMPB(b + 4));
        if (b + 2 < nb) kv8_qk(C, qf, srow, b + 2, lane);
    }
    kv8_issue(A, KV8, vvo, iv, 0);
    kv8_issue(B, KV8, vvo, iv, CLAMPB(1));
    LDS_WAIT();
#pragma unroll 1
    for (int h = 0; h < 8; ++h) {
        float sv[4]; float mx = -__builtin_inff();
#pragma unroll
        for (int jj = 0; jj < 4; ++jj) { const int j = lane + 64 * jj; const float s = sbuf[h * 256 + j]; sv[jj] = (j < nsel) ? s : -__builtin_inff(); mx = fmaxf(mx, sv[jj]); }
        mx = wave_max(mx); float sm = 0.f;
#pragma unroll
        for (int jj = 0; jj < 4; ++jj) { const int j = lane + 64 * jj; sv[jj] = (j < nsel) ? __expf(sv[jj] - mx) : 0.f; sm += sv[jj]; }
        sm = wave_sum(sm); const float inv = 1.f / sm;
#pragma unroll
        for (int jj = 0; jj < 4; ++jj) sbuf[h * 256 + lane + 64 * jj] = sv[jj] * inv;
    }
    LDS_WAIT();
    f32x2v o[8];
#pragma unroll
    for (int i = 0; i < 8; ++i) o[i] = (f32x2v){0.f, 0.f};
#pragma unroll 1
    for (int b = 0; b < nb; b += 3) {
        kv8_issue(C, KV8, vvo, iv, CLAMPB(b + 2));
        kv8_pv(A, o, srow, b);
        kv8_issue(A, KV8, vvo, iv, CLAMPB(b + 3));
        if (b + 1 < nb) kv8_pv(B, o, srow, b + 1);
        kv8_issue(B, KV8, vvo, iv, CLAMPB(b + 4));
        if (b + 2 < nb) kv8_pv(C, o, srow, b + 2);
    }
#undef CLAMPB
    u32x4 o0, o1;
    o0.x = cvt_pk_bf16(o[0].x, o[0].y); o0.y = cvt_pk_bf16(o[1].x, o[1].y); o0.z = cvt_pk_bf16(o[2].x, o[2].y); o0.w = cvt_pk_bf16(o[3].x, o[3].y);
    o1.x = cvt_pk_bf16(o[4].x, o[4].y); o1.y = cvt_pk_bf16(o[5].x, o[5].y); o1.z = cvt_pk_bf16(o[6].x, o[6].y); o1.w = cvt_pk_bf16(o[7].x, o[7].y);
    u32x4* yp = (u32x4*)(YMIX + (size_t)t * D_ + 1024 + lane * 16);
    yp[0] = o0; yp[1] = o1;
    LDS_WAIT();
}

#define XB_TMO      128
#define XB_XCNT(j)  (256  + 64 * (j))
#define XB_XSUB(j)  (1280 + 64 * (j))
#define XB_XGEN(j)  (2304 + 64 * (j))
#define XB_TOP      3328
#define XB_TOPGEN   3392
#define XB_SPIN_CAP (1u << 23)
__device__ __forceinline__ unsigned xb_ld(unsigned* p)              { return __hip_atomic_load(p, __ATOMIC_RELAXED, __HIP_MEMORY_SCOPE_AGENT); }
__device__ __forceinline__ unsigned xb_add(unsigned* p, unsigned v) { return __hip_atomic_fetch_add(p, v, __ATOMIC_RELAXED, __HIP_MEMORY_SCOPE_AGENT); }
__device__ __forceinline__ unsigned xb_xcc_id() { return (unsigned)__builtin_amdgcn_s_getreg((3 << 11) | 20) & 0xFu; }
#define XB_SPIN(cond, bar) do { unsigned _sp = 0; while (cond) { __builtin_amdgcn_s_sleep(1); \
    if ((++_sp & 255u) == 0u) { if (xb_ld(&(bar)[XB_TMO])) break; if (_sp > XB_SPIN_CAP) { atomicAdd(&(bar)[XB_TMO], 1u); break; } } } } while (0)
__device__ __forceinline__ void xcd_barrier_complete(unsigned* bar, unsigned x, unsigned& nloc, unsigned& nx) {
    const unsigned G = gridDim.x * gridDim.y * gridDim.z;
    unsigned sum, cnt, mine, sp = 0u;
    for (;;) {
        sum = 0u; cnt = 0u; mine = 0u;
#pragma unroll
        for (unsigned j = 0; j < 16; ++j) { const unsigned c = xb_ld(&bar[XB_XCNT(j)]); sum += c; cnt += (c > 0u) ? 1u : 0u; mine = (j == x) ? c : mine; }
        if (sum == G) break;
        __builtin_amdgcn_s_sleep(1);
        if ((++sp & 255u) == 0u) { if (xb_ld(&bar[XB_TMO])) break; if (sp > XB_SPIN_CAP) { atomicAdd(&bar[XB_TMO], 1u); break; } }
    }
    nloc = mine > 0u ? mine : 1u; nx = cnt > 0u ? cnt : 1u;
}
__device__ __forceinline__ void xcd_barrier(unsigned* bar, volatile LAS unsigned* st, bool leader) {
    asm volatile("s_waitcnt vmcnt(0)" ::: "memory");
    __syncthreads();
    if (leader) {
        __builtin_amdgcn_s_waitcnt(0);
        const unsigned x = xb_xcc_id();
        unsigned nloc = st[0], nx = st[1];
        if (nloc == 0u) { xcd_barrier_complete(bar, x, nloc, nx); st[0] = nloc; st[1] = nx; }
        const unsigned old = xb_add(&bar[XB_XSUB(x)], 1u);
        const unsigned gen = old / nloc;
        if (old + 1u == (gen + 1u) * nloc) {
            __builtin_amdgcn_fence(__ATOMIC_RELEASE, "agent");
            asm volatile("s_waitcnt vmcnt(0)" ::: "memory");
            const unsigned og = xb_add(&bar[XB_TOP], 1u);
            const unsigned tg = og / nx;
            if (og + 1u == (tg + 1u) * nx) xb_add(&bar[XB_TOPGEN], 1u);
            else XB_SPIN(xb_ld(&bar[XB_TOPGEN]) == tg, bar);
            __builtin_amdgcn_fence(__ATOMIC_ACQUIRE, "agent");
            xb_add(&bar[XB_XGEN(x)], 1u);
            asm volatile("s_waitcnt vmcnt(0)" ::: "memory");
        } else {
            XB_SPIN(xb_ld(&bar[XB_XGEN(x)]) == gen, bar);
            __builtin_amdgcn_fence(__ATOMIC_ACQUIRE, "agent");
            asm volatile("s_waitcnt vmcnt(0)" ::: "memory");
        }
    }
    __syncthreads();
}

__global__ void __launch_bounds__(512, 2) mega(Params p) {
    extern __shared__ __attribute__((aligned(16))) unsigned char smem[];
    cg::grid_group grid = cg::this_grid();
    LAS unsigned char* lds = (LAS unsigned char*)smem;
    const int wave = __builtin_amdgcn_readfirstlane((int)threadIdx.x >> 6);
    const int nblk = gridDim.x, bid = blockIdx.x, gw = bid * 8 + wave, ngw = nblk * 8;
#define PHASE_IDS() const int lane = lane_id(), tid = wave * 64 + lane; (void)tid; (void)lane
    const float* x = p.in[0]; const float* attn_g = p.in[1]; const float* w_in = p.in[2]; const float* pool_w = p.in[3]; const float* pool_scale = p.in[4];
    const float* qn_g = p.in[5]; const float* kn_g = p.in[6]; const float* w_out = p.in[7]; const float* ffn_g = p.in[8]; const float* w_up = p.in[9];
    const float* conv_w = p.in[10]; const float* conv_b = p.in[11]; const float* w_down = p.in[12];
    bf16_t* WinT = (bf16_t*)(p.ws + WS_WIN); bf16_t* WoutT = (bf16_t*)(p.ws + WS_WOUT); bf16_t* WupT = (bf16_t*)(p.ws + WS_WUP); bf16_t* WdT = (bf16_t*)(p.ws + WS_WDN);
    bf16_t* PwT = (bf16_t*)(p.ws + WS_PW); bf16_t* Hb = (bf16_t*)(p.ws + WS_H); bf16_t* H = Hb + 2 * D_; bf16_t* Z = (bf16_t*)(p.ws + WS_Z);
    bf16_t* YMIX = (bf16_t*)(p.ws + WS_YMIX); bf16_t* Dp = (bf16_t*)(p.ws + WS_DP); int* SEL = (int*)(p.ws + WS_SEL); bf16_t* ACT = (bf16_t*)(p.ws + WS_ACT); unsigned char* KV8 = p.ws + WS_KV8; bf16_t* KI = (bf16_t*)(p.ws + WS_KI);
    float* out = p.out;
    unsigned* gbar = (unsigned*)(p.ws + WS_BAR); volatile LAS unsigned* gst = (volatile LAS unsigned*)(lds + LDS_BARST);
    { const bool ld0 = (wave == 0) && (lane_id() == 0);
      if (ld0) { gst[0] = 0u; gst[1] = 0u; (void)xb_add(&gbar[XB_XCNT(xb_xcc_id())], 1u); } }
#define GRID_BAR() xcd_barrier(gbar, gst, (wave == 0) && (lane_id() == 0))

#ifdef DUP_P0
    for (int rep0 = 0; rep0 < 2; ++rep0)
#endif
    {
        PHASE_IDS();
        LAS float* scr = (LAS float*)lds + wave * (64 * 65);
        constexpr int NB_IN = ZLD / 64, NB_UP = 2 * DFF / 64;
        constexpr int I_IN = 32 * NB_IN, I_OUT = 32 * 32, I_UP = 32 * NB_UP, I_DN = (DFF / 64) * 32, I_PW = 4 * 4 * 4;
        constexpr int NITEMS = I_IN + I_OUT + I_UP + I_DN + I_PW;
        for (int it = gw; it < NITEMS; it += ngw) {
            int r = it;
            if (r < I_IN) { const int nb = r % NB_IN, kb = r / NB_IN, n0 = nb * 64; int nv = DIN - n0; nv = nv < 0 ? 0 : (nv > 64 ? 64 : nv);
                transpose_item(w_in, DIN, n0, nv, WinT, D_, n0, kb * 64, nullptr, scr, lane); continue; }
            r -= I_IN;
            if (r < I_OUT) { const int nb = r % 32, kb = r / 32; transpose_item(w_out, D_, nb * 64, 64, WoutT, D_, nb * 64, kb * 64, nullptr, scr, lane); continue; }
            r -= I_OUT;
            if (r < I_UP) { const int nb = r % NB_UP, kb = r / NB_UP, n0 = nb * 64, tile = n0 >> 8, j = n0 & 255;
                const int src = (j < 128) ? (128 * tile + j) : (DFF + 128 * tile + (j - 128));
                transpose_item(w_up, 2 * DFF, src, 64, WupT, D_, n0, kb * 64, nullptr, scr, lane); continue; }
            r -= I_UP;
            if (r < I_DN) { const int nb = r % 32, kb = r / 32; transpose_item(w_down, D_, nb * 64, 64, WdT, DFF, nb * 64, kb * 64, nullptr, scr, lane); continue; }
            r -= I_DN;
            { const int g = r >> 4, rr = r & 15, nb = rr & 3, kb = rr >> 2;
              transpose_item(pool_w + (size_t)g * 65536, 256, nb * 64, 64, PwT + (size_t)g * 65536, 256, nb * 64, kb * 64, pool_scale + g * 256, scr, lane); }
        }
        for (int row = gw; row < S_; row += ngw) rmsnorm_row(x + (size_t)row * D_, attn_g, H + (size_t)row * D_, lane);
    }
    if (nblk == 0x7fffffff) grid.sync();
    GRID_BAR();
    {
        pg8::Gemm g{H, WinT, S_, ZLD, D_, (size_t)256 * D_ * 2}; pg8::StaticOrder S; S.init(S_, ZLD, nblk, bid); EpiStoreBf16 E{Z, ZLD, KI};
#ifndef SKIP_G1
        pg8::gemm_phase<EpiStoreBf16, pg8::StaticOrder, true, true>(lds, g, S, E, wave);
#endif
#ifdef DUP_G1
        pg8::gemm_phase<EpiStoreBf16, pg8::StaticOrder, true, true>(lds, g, S, E, wave);
#endif
    }
    GRID_BAR();
    {
        PHASE_IDS();
#pragma unroll 1
        for (int step2 = 0; step2 < 2; ++step2) {
        if ((step2 ^ (bid & 1)) == 0) {
#ifdef DUP_P2A
        for (int rep2 = 0; rep2 < 2; ++rep2)
#endif
        for (size_t it = (size_t)bid * 512 + tid; it < (size_t)S_ * 128; it += (size_t)nblk * 512) {
            const int t = (int)(it >> 7), c = ((int)it & 127) * 8, g = c >> 8, w = 2 << g;
            const int lo = (t + 1 - w) > 0 ? (t + 1 - w) : 0; const float inv = 1.f / (float)(t + 1 - lo);
            float s[8] = {0.f, 0.f, 0.f, 0.f, 0.f, 0.f, 0.f, 0.f}; u32x4 v = {0u, 0u, 0u, 0u};
            for (int tt = lo; tt <= t; ++tt) { v = *(const u32x4*)(Z + (size_t)tt * ZLD + c);
                s[0] += bf_lo(v.x); s[1] += bf_hi(v.x); s[2] += bf_lo(v.y); s[3] += bf_hi(v.y); s[4] += bf_lo(v.z); s[5] += bf_hi(v.z); s[6] += bf_lo(v.w); s[7] += bf_hi(v.w); }
            u32x4 o; o.x = cvt_pk_bf16(s[0] * inv - bf_lo(v.x), s[1] * inv - bf_hi(v.x)); o.y = cvt_pk_bf16(s[2] * inv - bf_lo(v.y), s[3] * inv - bf_hi(v.y));
            o.z = cvt_pk_bf16(s[4] * inv - bf_lo(v.z), s[5] * inv - bf_hi(v.z)); o.w = cvt_pk_bf16(s[6] * inv - bf_lo(v.w), s[7] * inv - bf_hi(v.w));
            *(u32x4*)(Dp + ((size_t)g * S_ + t) * 256 + (c & 255)) = o;
        }
        {
            const int d0 = (lane & 7) * 16;
            float gq[16];
#pragma unroll
            for (int e = 0; e < 16; ++e) gq[e] = qn_g[d0 + e] * kn_g[d0 + e] * 0.08838834764831845f;
            for (int t = gw; t < S_; t += ngw) {
#pragma unroll
                for (int which = 0; which < 2; ++which) {
                    u32x4* ptr = (u32x4*)(Z + (size_t)t * ZLD + (which ? OFF_K : OFF_Q) + lane * 16);
                    const u32x4 a = ptr[0], b = ptr[1];
                    float f[16] = {bf_lo(a.x), bf_hi(a.x), bf_lo(a.y), bf_hi(a.y), bf_lo(a.z), bf_hi(a.z), bf_lo(a.w), bf_hi(a.w), bf_lo(b.x), bf_hi(b.x), bf_lo(b.y), bf_hi(b.y), bf_lo(b.z), bf_hi(b.z), bf_lo(b.w), bf_hi(b.w)};
                    float ss = 0.f;
#pragma unroll
                    for (int e = 0; e < 16; ++e) ss = fmaf(f[e], f[e], ss);
                    ss += __shfl_xor(ss, 1); ss += __shfl_xor(ss, 2); ss += __shfl_xor(ss, 4);
                    const float rinv = 1.f / sqrtf(ss * (1.f / 128.f) + EPS_);
#pragma unroll
                    for (int e = 0; e < 16; ++e) f[e] = f[e] * rinv * (which ? 1.f : gq[e]);
                    if (which == 0) {
                        u32x4 oa, ob; oa.x = cvt_pk_bf16(f[0], f[1]); oa.y = cvt_pk_bf16(f[2], f[3]); oa.z = cvt_pk_bf16(f[4], f[5]); oa.w = cvt_pk_bf16(f[6], f[7]);
                        ob.x = cvt_pk_bf16(f[8], f[9]); ob.y = cvt_pk_bf16(f[10], f[11]); ob.z = cvt_pk_bf16(f[12], f[13]); ob.w = cvt_pk_bf16(f[14], f[15]);
                        ptr[0] = oa; ptr[1] = ob;
                    } else {
                        int w0 = 0, w1 = 0, w2 = 0, w3 = 0;
                        w0 = __builtin_amdgcn_cvt_pk_fp8_f32(f[0], f[1], w0, false); w0 = __builtin_amdgcn_cvt_pk_fp8_f32(f[2], f[3], w0, true);
                        w1 = __builtin_amdgcn_cvt_pk_fp8_f32(f[4], f[5], w1, false); w1 = __builtin_amdgcn_cvt_pk_fp8_f32(f[6], f[7], w1, true);
                        w2 = __builtin_amdgcn_cvt_pk_fp8_f32(f[8], f[9], w2, false); w2 = __builtin_amdgcn_cvt_pk_fp8_f32(f[10], f[11], w2, true);
                        w3 = __builtin_amdgcn_cvt_pk_fp8_f32(f[12], f[13], w3, false); w3 = __builtin_amdgcn_cvt_pk_fp8_f32(f[14], f[15], w3, true);
                        u32x4 o8; o8.x = (unsigned)w0; o8.y = (unsigned)w1; o8.z = (unsigned)w2; o8.w = (unsigned)w3;
                        *(u32x4*)(KV8 + (size_t)t * 2048 + lane * 16) = o8;
                    }
                }
                {
                    const u32x4* ptr = (const u32x4*)(Z + (size_t)t * ZLD + OFF_V + lane * 16);
                    const u32x4 a = ptr[0], b = ptr[1];
                    int w0 = 0, w1 = 0, w2 = 0, w3 = 0;
                    w0 = __builtin_amdgcn_cvt_pk_fp8_f32(bf_lo(a.x), bf_hi(a.x), w0, false); w0 = __builtin_amdgcn_cvt_pk_fp8_f32(bf_lo(a.y), bf_hi(a.y), w0, true);
                    w1 = __builtin_amdgcn_cvt_pk_fp8_f32(bf_lo(a.z), bf_hi(a.z), w1, false); w1 = __builtin_amdgcn_cvt_pk_fp8_f32(bf_lo(a.w), bf_hi(a.w), w1, true);
                    w2 = __builtin_amdgcn_cvt_pk_fp8_f32(bf_lo(b.x), bf_hi(b.x), w2, false); w2 = __builtin_amdgcn_cvt_pk_fp8_f32(bf_lo(b.y), bf_hi(b.y), w2, true);
                    w3 = __builtin_amdgcn_cvt_pk_fp8_f32(bf_lo(b.z), bf_hi(b.z), w3, false); w3 = __builtin_amdgcn_cvt_pk_fp8_f32(bf_lo(b.w), bf_hi(b.w), w3, true);
                    u32x4 o8; o8.x = (unsigned)w0; o8.y = (unsigned)w1; o8.z = (unsigned)w2; o8.w = (unsigned)w3;
                    *(u32x4*)(KV8 + (size_t)t * 2048 + 1024 + lane * 16) = o8;
                }
            }
        }
        } else {
        {
            __syncthreads();
#ifdef DUP_IDX
            for (int rep = 0; rep < 2; ++rep)
#endif
            for (int base = 0; base < 512; base += nblk) {
                const int i = base + bid;
                if (i < 512) {
#ifndef SKIP_IDX
                    indexer_block16(Z, KI, SEL, i, lds, wave);
                    indexer_block16(Z, KI, SEL, 1023 - i, lds, wave);
#endif
                }
            }
        }
        }
        }
    }
    GRID_BAR();
    {
        int kpool = 256; asm volatile("" : "+s"(kpool));
        pg8::Gemm g{Dp, PwT, 4 * S_, 1024, kpool, (size_t)256 * 256 * 2}; PoolOrder S{nblk, bid}; EpiPool E{YMIX};
#ifndef SKIP_G3
        pg8::gemm_phase<EpiPool, PoolOrder, true, true>(lds, g, S, E, wave);
#endif
        __syncthreads();
        LAS float* sbuf = (LAS float*)lds + wave * 2048;
#ifndef SKIP_ATT
        for (int t = gw; t < S_; t += ngw) attn_query8(KV8, Z, SEL, YMIX, t, sbuf);
#endif
#ifdef DUP_ATT
        for (int t = gw; t < S_; t += ngw) attn_query8(KV8, Z, SEL, YMIX, t, sbuf);
#endif
    }
    GRID_BAR();
    {
        pg8::Gemm g{YMIX, WoutT, S_, D_, D_, (size_t)256 * D_ * 2}; pg8::StaticOrder S; S.init(S_, D_, nblk, bid); EpiResid E{x, out};
#ifndef SKIP_G4
        pg8::gemm_phase<EpiResid, pg8::StaticOrder, true, true>(lds, g, S, E, wave);
#endif
#ifdef DUP_G4
        pg8::gemm_phase<EpiResid, pg8::StaticOrder, true, true>(lds, g, S, E, wave);
#endif
    }
    GRID_BAR();
    {
        PHASE_IDS();
#ifdef DUP_P5
        for (int rep5 = 0; rep5 < 2; ++rep5)
#endif
        for (int row = gw; row < S_; row += ngw) rmsnorm_row(out + (size_t)row * D_, ffn_g, H + (size_t)row * D_, lane);
        if (bid == 0) { u32x4 z = {0u, 0u, 0u, 0u};
            for (int i = tid; i < 2 * D_ / 8; i += 512) ((u32x4*)Hb)[i] = z;
            for (int i = tid; i < 126 * D_ / 8; i += 512) ((u32x4*)(H + (size_t)S_ * D_))[i] = z; }
    }
    GRID_BAR();
    {
        pg8::Gemm g{Hb, WupT, UP_TILES * 256, 2 * DFF, D_, (size_t)UP_ROWS * D_ * 2}; pg8::StaticOrder S; S.init(UP_TILES * 256, 2 * DFF, nblk, bid);
        EpiUp E{ACT, conv_w, conv_b, (LAS f32x4*)(lds + LDS_XL)};
#ifndef SKIP_G6
        pg8::gemm_phase<EpiUp, pg8::StaticOrder, true, true>(lds, g, S, E, wave);
#endif
#ifdef DUP_G6
        pg8::gemm_phase<EpiUp, pg8::StaticOrder, true, true>(lds, g, S, E, wave);
#endif
    }
    GRID_BAR();
    {
        pg8::Gemm g{ACT, WdT, S_, D_, DFF, (size_t)256 * DFF * 2}; pg8::StaticOrder S; S.init(S_, D_, nblk, bid); EpiResid E{out, out};
#ifndef SKIP_G7
        pg8::gemm_phase<EpiResid, pg8::StaticOrder, true, true>(lds, g, S, E, wave);
#endif
    }
}

extern "C" void kernel_launch(void* const* d_in, const int* in_sizes, int n_in, void* d_out, int out_size, void* d_ws, size_t ws_size, hipStream_t stream) {
    static int grid = 0;
    if (grid == 0) {
        if (n_in != 13 || in_sizes[0] != S_ * D_ || out_size != S_ * D_ || ws_size < WS_END) { fprintf(stderr, "kernel_launch: unexpected shapes (n_in %d, ws %zu, need %zu)\n", n_in, ws_size, (size_t)WS_END); grid = -1; return; }
        int dev = 0, cus = 0, per_cu = 0;
        if (hipGetDevice(&dev) != hipSuccess || hipDeviceGetAttribute(&cus, hipDeviceAttributeMultiprocessorCount, dev) != hipSuccess) { grid = -1; return; }
        if (hipFuncSetAttribute((const void*)mega, hipFuncAttributeMaxDynamicSharedMemorySize, LDS_BYTES) != hipSuccess) { fprintf(stderr, "kernel_launch: hipFuncSetAttribute failed\n"); grid = -1; return; }
        if (hipOccupancyMaxActiveBlocksPerMultiprocessor(&per_cu, (const void*)mega, 512, LDS_BYTES) != hipSuccess || per_cu < 1) { fprintf(stderr, "kernel_launch: occupancy query failed (%d)\n", per_cu); (void)hipGetLastError(); per_cu = 1; }
        grid = cus * per_cu;
    }
    if (grid < 0) return;
    Params p{};
    for (int i = 0; i < 13; ++i) p.in[i] = (const float*)d_in[i];
    p.out = (float*)d_out; p.ws = (unsigned char*)d_ws;
    if (hipMemsetAsync((char*)d_ws + WS_BAR, 0, 16384, stream) != hipSuccess) { fprintf(stderr, "kernel_launch: memset of the barrier words failed\n"); return; }
    void* args[] = {&p};
    const hipError_t e = hipLaunchCooperativeKernel((const void*)mega, dim3(grid), dim3(512), args, LDS_BYTES, stream);
    if (e != hipSuccess) fprintf(stderr, "kernel_launch: cooperative launch failed: %s (grid %d)\n", hipGetErrorString(e), grid);
}
```

```cpp
#include <hip/hip_runtime.h>
#include <hip/hip_cooperative_groups.h>
#include <cstdio>
#include <cstdint>
namespace cg = cooperative_groups;
namespace pg8 {
#define PG8_LAS __attribute__((address_space(3)))
typedef unsigned short bf16_t;
typedef short bf16x8 __attribute__((ext_vector_type(8)));
typedef float f32x4 __attribute__((ext_vector_type(4)));
typedef unsigned u32x4 __attribute__((ext_vector_type(4)));
constexpr int BM = 256, BK = 64, HALF = 128, HTB = HALF * BK * 2  , STAGE_BYTES = 8 * HTB, NXCD = 8, WGM = 8;

__host__ __device__ __forceinline__ int lds_byte(int r, int c) { const int st = (r >> 4) * 2 + (c >> 5), rr = r & 15, cc = c & 31, ob = rr * 64 + cc * 2; return st * 1024 + (ob ^ (((ob >> 9) & 1) << 5)); }
__host__ __device__ __forceinline__ void stage_rc(int b, int& R, int& C) { const int st = b / 1024, sb = b % 1024, swz = sb ^ (((sb >> 9) & 1) << 5); R = (st >> 1) * 16 + swz / 64; C = (st & 1) * 32 + (swz % 64) / 2; }
__host__ __device__ __forceinline__ int perm32(int rho) { const int n = rho >> 4, i = rho & 15; return 8 * (i >> 2) + 4 * n + (i & 3); }

struct Unit { int pm, pn; };
struct Gemm { const bf16_t* A; const bf16_t* Bt; int M, N, K; size_t a_tstep; };

struct StaticOrder {
    int nM, nN, nwg, G, c;
    __host__ __device__ void init(int M, int N, int G_, int c_) { nM = M / BM; nN = N / BM; nwg = nM * nN; G = G_; c = c_; }
    __host__ __device__ bool next(int i, Unit& u) const {
        const long L = (long)i * G + c; if (L >= nwg) return false;
        int wgid = (int)L; { const int q = nwg / NXCD, r = nwg % NXCD, xcd = wgid % NXCD, off = wgid / NXCD; wgid = (xcd < r ? xcd * (q + 1) : r * (q + 1) + (xcd - r) * q) + off; }
        const int nig = WGM * nN, gid = wgid / nig, fm = gid * WGM, gsz = (nM - fm) < WGM ? (nM - fm) : WGM;
        u.pm = fm + ((wgid % nig) % gsz); u.pn = (wgid % nig) / gsz; return true;
    }
    __device__ __forceinline__ void a_ready(const Unit&) const {}
    __device__ __forceinline__ void done(const Unit&) const {}
};
__device__ __forceinline__ unsigned cvt_pk_bf16(float lo, float hi) { unsigned r; asm volatile("v_cvt_pk_bf16_f32 %0, %1, %2" : "=v"(r) : "v"(lo), "v"(hi)); return r; }
typedef float f32x2 __attribute__((ext_vector_type(2)));
template <class Epi, class Sched, bool ALIGN_EPI = false, bool SP2 = false>
__device__ __forceinline__ void gemm_phase(PG8_LAS unsigned char* lds, const Gemm g, const Sched& S, const Epi& E, const int wid  ) {
    int lane; asm volatile("v_mbcnt_lo_u32_b32 %0, -1, 0\n\tv_mbcnt_hi_u32_b32 %0, -1, %0\n\ts_nop 1" : "=v"(lane));
    const int tid = wid * 64 + lane, wr = wid >> 2, wc = wid & 3, fr = lane & 15, fq = lane >> 4;
    const int K = g.K, nt = K / BK;
    unsigned voffA[2], voffB[2];
#pragma unroll
    for (int i = 0; i < 2; ++i) { int R, C; stage_rc(tid * 16 + i * 8192, R, C); const int Rb = Epi::PERM ? ((R & ~31) + perm32(R & 31)) : R;
        voffA[i] = (unsigned)(R * K + C) * 2u; voffB[i] = (unsigned)(Rb * K + C) * 2u; }
    const size_t kstep = (size_t)(BK * 2);
    const size_t hstep = (size_t)HALF * K * 2;
    const size_t tstep = 2 * hstep;
    const unsigned ldsw = (unsigned)wid * 1024u;
    const int aoff = lds_byte(wr * 64 + fr, fq * 8), boff = lds_byte(wc * 32 + fr, fq * 8);
#define PG8_SA(b, h) (((b) * 2 + (h)) * HTB)
#define PG8_SB(b, h) ((4 + (b) * 2 + (h)) * HTB)
#define PG8_STAGE(bufoff, gbase, voff) do { _Pragma("unroll") for (int _i = 0; _i < 2; ++_i) \
        __builtin_amdgcn_global_load_lds((const unsigned*)((const char*)(gbase) + (voff)[_i]), (PG8_LAS unsigned*)(lds + (bufoff) + ldsw + _i * 8192), 16, 0, 0); } while (0)
#define PG8_LDA(dst, b, h) do { _Pragma("unroll") for (int m = 0; m < 4; ++m) _Pragma("unroll") for (int k = 0; k < 2; ++k) dst[m][k] = *(const PG8_LAS bf16x8*)(lds + PG8_SA(b, h) + aoff + m * 2048 + k * 1024); } while (0)
#define PG8_LDB(dst, b, h) do { _Pragma("unroll") for (int n = 0; n < 2; ++n) _Pragma("unroll") for (int k = 0; k < 2; ++k) dst[n][k] = *(const PG8_LAS bf16x8*)(lds + PG8_SB(b, h) + boff + n * 2048 + k * 1024); } while (0)
#define PG8_MMA(ai, bj, At, Bt) do { __builtin_amdgcn_s_setprio(1); _Pragma("unroll") for (int m = 0; m < 4; ++m) _Pragma("unroll") for (int n = 0; n < 2; ++n) _Pragma("unroll") for (int k = 0; k < 2; ++k) \
        acc[ai][bj][m][n] = __builtin_amdgcn_mfma_f32_16x16x32_bf16(Bt[n][k], At[m][k], acc[ai][bj][m][n], 0, 0, 0); __builtin_amdgcn_s_setprio(0); } while (0)
#define PG8_WAIT_V(n) asm volatile("s_waitcnt vmcnt(" #n ")" ::: "memory")
#define PG8_WAIT_L(n) asm volatile("s_waitcnt lgkmcnt(" #n ")" ::: "memory")
#define PG8_BAR __builtin_amdgcn_s_barrier()
#define PG8_SCHED __builtin_amdgcn_sched_barrier(0)
    Unit cur, nxt; int ui = 0;
    if (!S.next(0, cur)) return;
    f32x4 acc[2][2][4][2];
#pragma unroll
    for (int a = 0; a < 2; ++a)
#pragma unroll
        for (int b = 0; b < 2; ++b)
#pragma unroll
            for (int m = 0; m < 4; ++m)
#pragma unroll
                for (int n = 0; n < 2; ++n) acc[a][b][m][n] = (f32x4){0.f, 0.f, 0.f, 0.f};
    bf16x8 At[4][2], B0[2][2], B1[2][2];
    const char* cA = (const char*)g.A + (size_t)cur.pm * g.a_tstep; const char* cB = (const char*)g.Bt + (size_t)cur.pn * tstep;
    S.a_ready(cur);
    if constexpr (SP2) {
        PG8_STAGE(PG8_SB(0, 0), cB, voffB); PG8_STAGE(PG8_SB(0, 1), cB + hstep, voffB); PG8_STAGE(PG8_SA(0, 0), cA, voffA); PG8_STAGE(PG8_SA(0, 1), cA + hstep, voffA);
        if (wr == 1) PG8_BAR;
        PG8_WAIT_V(2); PG8_BAR;
        PG8_STAGE(PG8_SB(1, 0), cB + kstep, voffB); PG8_STAGE(PG8_SA(1, 0), cA + kstep, voffA); PG8_STAGE(PG8_SB(1, 1), cB + hstep + kstep, voffB);
        PG8_WAIT_V(6); PG8_BAR;
    } else {
        PG8_STAGE(PG8_SB(0, 0), cB, voffB); PG8_STAGE(PG8_SA(0, 0), cA, voffA); PG8_STAGE(PG8_SB(0, 1), cB + hstep, voffB); PG8_STAGE(PG8_SA(0, 1), cA + hstep, voffA);
        if (wr == 1) PG8_BAR;
        PG8_WAIT_V(4); PG8_BAR;
        PG8_STAGE(PG8_SB(1, 0), cB + kstep, voffB); PG8_STAGE(PG8_SA(1, 0), cA + kstep, voffA); PG8_STAGE(PG8_SB(1, 1), cB + hstep + kstep, voffB);
        PG8_WAIT_V(6); PG8_BAR;
    }
    for (;;) {
        const bool has_next = S.next(ui + 1, nxt);
        const char* nA = has_next ? (const char*)g.A + (size_t)nxt.pm * g.a_tstep : cA; const char* nB = has_next ? (const char*)g.Bt + (size_t)nxt.pn * tstep : cB;
        for (int t = 0; t < nt; t += 2) {
            const bool last = (t == nt - 2);
            const char* a1 = cA + (size_t)(t + 1) * kstep;
            const char* a2 = last ? nA : cA + (size_t)(t + 2) * kstep; const char* b2 = last ? nB : cB + (size_t)(t + 2) * kstep;
            const char* a3 = a2 + kstep; const char* b3 = b2 + kstep;
            if (last && has_next) S.a_ready(nxt);
            if constexpr (SP2) {
            PG8_LDB(B0, 0, 0); PG8_LDB(B1, 0, 1); PG8_SCHED; PG8_LDA(At, 0, 0); PG8_STAGE(PG8_SA(1, 1), a1 + hstep, voffA);
            PG8_WAIT_V(8); PG8_WAIT_L(0); PG8_BAR; PG8_MMA(0, 0, At, B0); PG8_MMA(0, 1, At, B1); PG8_BAR; PG8_SCHED;
            PG8_LDA(At, 0, 1); PG8_STAGE(PG8_SB(0, 0), b2, voffB); PG8_STAGE(PG8_SB(0, 1), b2 + hstep, voffB); PG8_STAGE(PG8_SA(0, 0), a2, voffA);
            PG8_WAIT_V(8); PG8_WAIT_L(0); PG8_BAR; PG8_MMA(1, 0, At, B0); PG8_MMA(1, 1, At, B1); PG8_BAR; PG8_SCHED;
            PG8_LDB(B0, 1, 0); PG8_LDB(B1, 1, 1); PG8_SCHED; PG8_LDA(At, 1, 0); PG8_STAGE(PG8_SA(0, 1), a2 + hstep, voffA);
            PG8_WAIT_V(8); PG8_WAIT_L(0); PG8_BAR; PG8_MMA(0, 0, At, B0); PG8_MMA(0, 1, At, B1); PG8_BAR; PG8_SCHED;
            PG8_LDA(At, 1, 1); PG8_STAGE(PG8_SB(1, 0), b3, voffB); PG8_STAGE(PG8_SB(1, 1), b3 + hstep, voffB); PG8_STAGE(PG8_SA(1, 0), a3, voffA);
            PG8_WAIT_V(8); PG8_WAIT_L(0); PG8_BAR; PG8_MMA(1, 0, At, B0); PG8_MMA(1, 1, At, B1); PG8_BAR; PG8_SCHED;
            } else {
            PG8_LDB(B0, 0, 0); PG8_SCHED; PG8_LDA(At, 0, 0); PG8_STAGE(PG8_SA(1, 1), a1 + hstep, voffA);
            PG8_WAIT_L(8); PG8_BAR; PG8_WAIT_L(0); PG8_MMA(0, 0, At, B0); PG8_BAR; PG8_SCHED;
            PG8_LDB(B1, 0, 1); PG8_STAGE(PG8_SB(0, 0), b2, voffB);
            PG8_BAR; PG8_WAIT_L(0); PG8_MMA(0, 1, At, B1); PG8_BAR;
            PG8_LDA(At, 0, 1); PG8_STAGE(PG8_SA(0, 0), a2, voffA);
            PG8_BAR; PG8_WAIT_L(0); PG8_MMA(1, 0, At, B0); PG8_BAR; PG8_SCHED;
            PG8_STAGE(PG8_SB(0, 1), b2 + hstep, voffB);
            PG8_WAIT_V(6); PG8_BAR; PG8_MMA(1, 1, At, B1); PG8_BAR;
            PG8_LDB(B0, 1, 0); PG8_SCHED; PG8_LDA(At, 1, 0); PG8_STAGE(PG8_SA(0, 1), a2 + hstep, voffA);
            PG8_WAIT_L(8); PG8_BAR; PG8_WAIT_L(0); PG8_MMA(0, 0, At, B0); PG8_BAR; PG8_SCHED;
            PG8_LDB(B1, 1, 1); PG8_STAGE(PG8_SB(1, 0), b3, voffB);
            PG8_BAR; PG8_WAIT_L(0); PG8_MMA(0, 1, At, B1); PG8_BAR;
            PG8_LDA(At, 1, 1); PG8_STAGE(PG8_SA(1, 0), a3, voffA);
            PG8_BAR; PG8_WAIT_L(0); PG8_MMA(1, 0, At, B0); PG8_BAR; PG8_SCHED;
            PG8_STAGE(PG8_SB(1, 1), b3 + hstep, voffB);
            PG8_WAIT_V(6); PG8_BAR; PG8_MMA(1, 1, At, B1); PG8_BAR;
            }
        }
        if constexpr (ALIGN_EPI) { if (wr == 0) PG8_BAR; }
        if constexpr (!Epi::AFTER_DRAIN) { E(acc, cur, wr, wc, fr, fq); S.done(cur); }
        if (!has_next) break;
#pragma unroll
        for (int a = 0; a < 2; ++a)
#pragma unroll
            for (int b = 0; b < 2; ++b)
#pragma unroll
                for (int m = 0; m < 4; ++m)
#pragma unroll
                    for (int n = 0; n < 2; ++n) acc[a][b][m][n] = (f32x4){0.f, 0.f, 0.f, 0.f};
        cur = nxt; cA = nA; cB = nB; ++ui;
        if constexpr (ALIGN_EPI) { if (wr == 1) PG8_BAR; }
    }
    PG8_WAIT_V(0);
    if constexpr (!ALIGN_EPI) { if (wr == 0) PG8_BAR; }
    PG8_BAR;
    if constexpr (Epi::AFTER_DRAIN) { E.fused(acc, cur, wr, wc, fr, fq, lds, wid, lane); S.done(cur); }
#undef PG8_SA
#undef PG8_SB
#undef PG8_STAGE
#undef PG8_LDA
#undef PG8_LDB
#undef PG8_MMA
#undef PG8_WAIT_V
#undef PG8_WAIT_L
#undef PG8_BAR
#undef PG8_SCHED
}
}

#define LAS __attribute__((address_space(3)))
using pg8::bf16_t; using pg8::bf16x8; using pg8::f32x4; using pg8::u32x4; using pg8::cvt_pk_bf16;
typedef unsigned u32x2 __attribute__((ext_vector_type(2)));
typedef float f32x16 __attribute__((ext_vector_type(16)));

constexpr int S_ = 16384, D_ = 2048, DIN = 5200, ZLD = 5376, DFF = 5632;
constexpr int OFF_Q = 1024, OFF_K = 2048, OFF_V = 3072, OFF_QI = 4096, OFF_KI = 5120, OFF_WI = 5184;
constexpr float EPS_ = 1e-6f;
constexpr int UP_ROWS = 254;
constexpr int UP_TILES = 65;
constexpr size_t WS_WIN = 0;
constexpr size_t WS_WOUT = WS_WIN + (size_t)ZLD * D_ * 2;
constexpr size_t WS_WUP = WS_WOUT + (size_t)D_ * D_ * 2;
constexpr size_t WS_WDN = WS_WUP + (size_t)2 * DFF * D_ * 2;
constexpr size_t WS_PW = WS_WDN + (size_t)D_ * DFF * 2;
constexpr size_t WS_H = WS_PW + (size_t)4 * 256 * 256 * 2;
constexpr size_t WS_Z = WS_H + (size_t)(S_ + 128) * D_ * 2;
constexpr size_t WS_YMIX = WS_Z + (size_t)S_ * ZLD * 2;
constexpr size_t WS_DP = WS_YMIX + (size_t)S_ * D_ * 2;
constexpr size_t WS_SEL = WS_DP + (size_t)S_ * 1024 * 2;
constexpr size_t WS_KV8 = WS_SEL + (size_t)S_ * 256 * 4;
constexpr size_t WS_KI = WS_KV8 + (size_t)S_ * 2048;
constexpr size_t WS_BAR = WS_KI + (size_t)S_ * 64 * 2;
constexpr size_t WS_END = WS_BAR + 16384;
constexpr size_t WS_ACT = WS_Z;
static_assert((size_t)S_ * DFF * 2 <= (size_t)S_ * ZLD * 2 + (size_t)S_ * D_ * 2, "act overlay");
constexpr int LDS_XL = pg8::STAGE_BYTES;
constexpr int LDS_BARST = pg8::STAGE_BYTES + 8192;
constexpr int LDS_BYTES = pg8::STAGE_BYTES + 8192 + 256;

struct Params { const float* in[13]; float* out; unsigned char* ws; };

__device__ __forceinline__ float bf_lo(unsigned v) { return __uint_as_float(v << 16); }
__device__ __forceinline__ float bf_hi(unsigned v) { return __uint_as_float(v & 0xffff0000u); }
__device__ __forceinline__ float wave_sum(float v) {
#pragma unroll
    for (int o = 1; o < 64; o <<= 1) v += __shfl_xor(v, o);
    return v;
}
__device__ __forceinline__ float wave_max(float v) {
#pragma unroll
    for (int o = 1; o < 64; o <<= 1) v = fmaxf(v, __shfl_xor(v, o));
    return v;
}
template <int CTRL> __device__ __forceinline__ float dpp_f(float v) { return __int_as_float(__builtin_amdgcn_update_dpp(0, __float_as_int(v), CTRL, 0xF, 0xF, true)); }
__device__ __forceinline__ float red16(float v) { v += dpp_f<0xB1>(v); v += dpp_f<0x4E>(v); v += dpp_f<0x141>(v); v += dpp_f<0x140>(v); return v; }
__device__ __forceinline__ f32x4 ror1(f32x4 v) { f32x4 r; r.x = dpp_f<0x121>(v.x); r.y = dpp_f<0x121>(v.y); r.z = dpp_f<0x121>(v.z); r.w = dpp_f<0x121>(v.w); return r; }
__device__ __forceinline__ f32x4 ror2(f32x4 v) { f32x4 r; r.x = dpp_f<0x122>(v.x); r.y = dpp_f<0x122>(v.y); r.z = dpp_f<0x122>(v.z); r.w = dpp_f<0x122>(v.w); return r; }
__device__ __forceinline__ f32x4 sel4(bool c, f32x4 a, f32x4 b) { f32x4 r; r.x = c ? a.x : b.x; r.y = c ? a.y : b.y; r.z = c ? a.z : b.z; r.w = c ? a.w : b.w; return r; }
__device__ __forceinline__ float dot8(u32x4 a, u32x4 b) { float acc = 0.f;
    asm volatile("v_dot2c_f32_bf16 %0, %1, %5\n\tv_dot2c_f32_bf16 %0, %2, %6\n\tv_dot2c_f32_bf16 %0, %3, %7\n\tv_dot2c_f32_bf16 %0, %4, %8\n\ts_nop 2"
                 : "+v"(acc) : "v"(a.x), "v"(a.y), "v"(a.z), "v"(a.w), "v"(b.x), "v"(b.y), "v"(b.z), "v"(b.w));
    return acc; }
__device__ __forceinline__ int mbcnt64(unsigned long long m) { return __builtin_amdgcn_mbcnt_hi((unsigned)(m >> 32), __builtin_amdgcn_mbcnt_lo((unsigned)m, 0)); }
#define LDS_WAIT() asm volatile("s_waitcnt lgkmcnt(0)" ::: "memory")
__device__ __forceinline__ int lane_id() { int l; asm volatile("v_mbcnt_lo_u32_b32 %0, -1, 0\n\tv_mbcnt_hi_u32_b32 %0, -1, %0\n\ts_nop 1" : "=v"(l)); return l; }

__device__ __forceinline__ void transpose_item(const float* __restrict__ W, int N, int src_n0, int n_valid, bf16_t* __restrict__ WT, int Kd, int dst_row0, int k0,
                                               const float* __restrict__ scale, LAS float* scr, int lane) {
    const int c4 = (lane & 15) * 4, kr = lane >> 4;
#pragma unroll 4
    for (int i = 0; i < 16; ++i) { const int kk = 4 * i + kr;
        f32x4 v = {0.f, 0.f, 0.f, 0.f};
        if (c4 < n_valid) v = *(const f32x4*)(W + (size_t)(k0 + kk) * N + src_n0 + c4);
        LAS float* d = scr + kk * 65 + c4; d[0] = v.x; d[1] = v.y; d[2] = v.z; d[3] = v.w; }
    LDS_WAIT();
    const int c8 = lane & 7;
#pragma unroll
    for (int j = 0; j < 8; ++j) { const int n = (lane >> 3) + 8 * j; const LAS float* s = scr + (8 * c8) * 65 + n;
        const float sc = (scale != nullptr && n < n_valid) ? scale[src_n0 + n] : 1.f;
        u32x4 o; o.x = cvt_pk_bf16(s[0 * 65] * sc, s[1 * 65] * sc); o.y = cvt_pk_bf16(s[2 * 65] * sc, s[3 * 65] * sc); o.z = cvt_pk_bf16(s[4 * 65] * sc, s[5 * 65] * sc); o.w = cvt_pk_bf16(s[6 * 65] * sc, s[7 * 65] * sc);
        *(u32x4*)(WT + (size_t)(dst_row0 + n) * Kd + k0 + 8 * c8) = o; }
    LDS_WAIT();
}
__device__ __forceinline__ void rmsnorm_row(const float* __restrict__ xrow, const float* __restrict__ g, bf16_t* __restrict__ orow, int lane) {
    const f32x4* xr = (const f32x4*)xrow + lane; f32x4 v[8]; float s = 0.f;
#pragma unroll
    for (int j = 0; j < 8; ++j) { v[j] = xr[64 * j]; s += (v[j].x * v[j].x + v[j].y * v[j].y) + (v[j].z * v[j].z + v[j].w * v[j].w); }
    const float r = 1.f / sqrtf(wave_sum(s) * (1.f / D_) + EPS_);
    const f32x4* gr = (const f32x4*)g + lane; u32x2* o8 = (u32x2*)orow + lane;
#pragma unroll
    for (int j = 0; j < 8; ++j) { const f32x4 gg = gr[64 * j]; u32x2 o; o.x = cvt_pk_bf16(v[j].x * r * gg.x, v[j].y * r * gg.y); o.y = cvt_pk_bf16(v[j].z * r * gg.z, v[j].w * r * gg.w); o8[64 * j] = o; }
}

struct EpiStoreBf16 {
    static constexpr bool PERM = true, AFTER_DRAIN = false;
    bf16_t* O; int ldc; bf16_t* KI;
    __device__ __forceinline__ void operator()(const f32x4 (&acc)[2][2][4][2], const pg8::Unit& u, int wr, int wc, int fr, int fq) const {
        const int row0 = u.pm * 256 + wr * 64 + fr, col0 = u.pn * 256 + wc * 32 + 8 * fq;
#pragma unroll
        for (int ai = 0; ai < 2; ++ai)
#pragma unroll
            for (int m = 0; m < 4; ++m) { bf16_t* rowp = O + (size_t)(row0 + ai * 128 + m * 16) * ldc + col0;
#pragma unroll
                for (int bj = 0; bj < 2; ++bj) { const f32x4 v0 = acc[ai][bj][m][0], v1 = acc[ai][bj][m][1];
                    u32x4 o; o.x = cvt_pk_bf16(v0.x, v0.y); o.y = cvt_pk_bf16(v0.z, v0.w); o.z = cvt_pk_bf16(v1.x, v1.y); o.w = cvt_pk_bf16(v1.z, v1.w);
                    *(u32x4*)(rowp + bj * 128) = o;
                    if (bj == 0 && u.pn == 20 && wc < 2) { const int row = row0 + ai * 128 + m * 16; ((u32x4*)KI)[(size_t)(row >> 5) * 256 + (4 * wc + fq) * 32 + (row & 31)] = o; } }
                asm volatile("" ::: "memory"); }
    }
};
struct EpiPool {
    static constexpr bool PERM = true, AFTER_DRAIN = false;
    bf16_t* O;
    __device__ __forceinline__ void operator()(const f32x4 (&acc)[2][2][4][2], const pg8::Unit& u, int wr, int wc, int fr, int fq) const {
        const int g = u.pm >> 6, row0 = (u.pm & 63) * 256 + wr * 64 + fr, col0 = g * 256 + wc * 32 + 8 * fq;
#pragma unroll
        for (int ai = 0; ai < 2; ++ai)
#pragma unroll
            for (int m = 0; m < 4; ++m) { bf16_t* rowp = O + (size_t)(row0 + ai * 128 + m * 16) * D_ + col0;
#pragma unroll
                for (int bj = 0; bj < 2; ++bj) { const f32x4 v0 = acc[ai][bj][m][0], v1 = acc[ai][bj][m][1];
                    u32x4 o; o.x = cvt_pk_bf16(v0.x, v0.y); o.y = cvt_pk_bf16(v0.z, v0.w); o.z = cvt_pk_bf16(v1.x, v1.y); o.w = cvt_pk_bf16(v1.z, v1.w);
                    *(u32x4*)(rowp + bj * 128) = o; } }
    }
};
struct PoolOrder {
    int G, c;
    __device__ __forceinline__ bool next(int i, pg8::Unit& u) const { const int L = i * G + c; if (L >= 256) return false; u.pm = L; u.pn = L >> 6; return true; }
    __device__ __forceinline__ void a_ready(const pg8::Unit&) const {}
    __device__ __forceinline__ void done(const pg8::Unit&) const {}
};
struct EpiResid {
    static constexpr bool PERM = false, AFTER_DRAIN = false;
    const float* src; float* dst;
    __device__ __forceinline__ void operator()(const f32x4 (&acc)[2][2][4][2], const pg8::Unit& u, int wr, int wc, int fr, int fq) const {
        const int row0 = u.pm * 256 + wr * 64 + fr, col0 = u.pn * 256 + wc * 32 + 4 * fq;
#pragma unroll
        for (int ai = 0; ai < 2; ++ai)
#pragma unroll
            for (int m = 0; m < 4; ++m) { const size_t off = (size_t)(row0 + ai * 128 + m * 16) * D_ + col0;
#pragma unroll
                for (int bj = 0; bj < 2; ++bj)
#pragma unroll
                    for (int n = 0; n < 2; ++n) { const f32x4 s = *(const f32x4*)(src + off + bj * 128 + n * 16); *(f32x4*)(dst + off + bj * 128 + n * 16) = s + acc[ai][bj][m][n]; }
                asm volatile("" ::: "memory"); }
    }
};
struct EpiUp {
    static constexpr bool PERM = true, AFTER_DRAIN = false;
    bf16_t* ACT; const float* cw; const float* cb; LAS f32x4* xl;
    __device__ __forceinline__ void operator()(const f32x4 (&acc)[2][2][4][2], const pg8::Unit& u, int wr, int wc, int fr, int fq) const {
        if (fr >= 14) {
#pragma unroll
            for (int ai = 0; ai < 2; ++ai)
#pragma unroll
                for (int bj = 0; bj < 2; ++bj)
#pragma unroll
                    for (int n = 0; n < 2; ++n) xl[((((wr * 4 + wc) * 2 + ai) * 2 + bj) * 2 + n) * 8 + fq * 2 + (fr - 14)] = acc[ai][bj][3][n];
        }
        LDS_WAIT();
        __builtin_amdgcn_s_barrier();
        asm volatile("" ::: "memory");
        const int t0 = UP_ROWS * u.pm - 2 + 64 * wr + fr, r0 = 64 * wr + fr;
        const int chb = 128 * u.pn + 32 * wc + 8 * fq;
        const int swr = wr ^ 1;
#pragma unroll
        for (int n = 0; n < 2; ++n) {
            const int ch = chb + 4 * n;
            f32x4 w0[2], w1[2], w2[2], bb[2];
#pragma unroll
            for (int bj = 0; bj < 2; ++bj) { const int c = ch + bj * DFF; w0[bj] = *(const f32x4*)(cw + c); w1[bj] = *(const f32x4*)(cw + 2 * DFF + c); w2[bj] = *(const f32x4*)(cw + 4 * DFF + c); bb[bj] = *(const f32x4*)(cb + c); }
#pragma unroll
            for (int ai = 0; ai < 2; ++ai) {
                const int sai = (wr == 1) ? ai : 0;
                f32x4 h14[2], h15[2], pr1[2], pr2[2];
#pragma unroll
                for (int bj = 0; bj < 2; ++bj) { const int base = ((((swr * 4 + wc) * 2 + sai) * 2 + bj) * 2 + n) * 8 + fq * 2; h14[bj] = xl[base]; h15[bj] = xl[base + 1]; pr1[bj] = h15[bj]; pr2[bj] = (fr == 0) ? h14[bj] : h15[bj]; }
#pragma unroll
                for (int m = 0; m < 4; ++m) {
                    f32x4 cc[2];
#pragma unroll
                    for (int bj = 0; bj < 2; ++bj) { const f32x4 X = acc[ai][bj][m][n], R1 = ror1(X), R2 = ror2(X);
                        const f32x4 p1 = sel4(fr >= 1, R1, pr1[bj]), p2 = sel4(fr >= 2, R2, pr2[bj]);
                        pr1[bj] = R1; pr2[bj] = R2;
                        cc[bj] = bb[bj] + w0[bj] * p2 + w1[bj] * p1 + w2[bj] * X; }
                    const f32x4 gt = cc[0], vl = cc[1]; f32x4 o;
                    o.x = gt.x * __builtin_amdgcn_rcpf(1.f + __expf(-gt.x)) * vl.x; o.y = gt.y * __builtin_amdgcn_rcpf(1.f + __expf(-gt.y)) * vl.y;
                    o.z = gt.z * __builtin_amdgcn_rcpf(1.f + __expf(-gt.z)) * vl.z; o.w = gt.w * __builtin_amdgcn_rcpf(1.f + __expf(-gt.w)) * vl.w;
                    const int t = t0 + 128 * ai + 16 * m, r = r0 + 128 * ai + 16 * m;
                    if (r >= 2 && t < S_) { u32x2 ov; ov.x = cvt_pk_bf16(o.x, o.y); ov.y = cvt_pk_bf16(o.z, o.w); *(u32x2*)(ACT + (size_t)t * DFF + ch) = ov; }
                }
            }
        }
    }
};

__device__ __forceinline__ unsigned f2ord(float f) { const unsigned u = __float_as_uint(f); return u ^ ((u >> 31) ? 0xFFFFFFFFu : 0x80000000u); }
__device__ __forceinline__ unsigned ord2bits(unsigned k) { return (k & 0x80000000u) ? (k ^ 0x80000000u) : ~k; }
__device__ __forceinline__ int topk_compact(LAS u32x2* buf, int cnt, float& tau) {
    const int lane = lane_id();
    LDS_WAIT();
    unsigned key[8], idx[8];
    unsigned kmin = 0xFFFFFFFFu, kmax = 0u;
#pragma unroll
    for (int j = 0; j < 8; ++j) { const int e = j * 64 + lane; const u32x2 v = buf[e]; const bool ok = e < cnt; const unsigned k = f2ord(__uint_as_float(v.x)); key[j] = ok ? k : 0u; idx[j] = v.y;
        kmin = (ok && k < kmin) ? k : kmin; kmax = (ok && k > kmax) ? k : kmax; }
#pragma unroll
    for (int o = 1; o < 64; o <<= 1) { const unsigned a = (unsigned)__shfl_xor((int)kmin, o), b = (unsigned)__shfl_xor((int)kmax, o); kmin = a < kmin ? a : kmin; kmax = b > kmax ? b : kmax; }
    const unsigned diff = (unsigned)__builtin_amdgcn_readfirstlane((int)(kmin ^ kmax));
    int bit = diff ? (31 - __builtin_clz(diff)) : -1;
    unsigned T = (bit >= 0) ? (unsigned)__builtin_amdgcn_readfirstlane((int)kmin) & ~((2u << bit) - 1u) : (unsigned)__builtin_amdgcn_readfirstlane((int)kmin);
    int cT = cnt;
#pragma unroll 1
    for (; bit >= 0 && cT != 256; --bit) {
        const unsigned cand = T | (1u << bit); int c = 0;
#pragma unroll
        for (int j = 0; j < 8; ++j) c += __builtin_popcountll(__builtin_amdgcn_ballot_w64(key[j] >= cand));
        if (c >= 256) { T = cand; cT = c; }
    }
    int base = 0;
    if (cT == 256) {
#pragma unroll
        for (int j = 0; j < 8; ++j) { const bool g = key[j] >= T; const unsigned long long mk = __builtin_amdgcn_ballot_w64(g); const int pos = base + mbcnt64(mk);
            if (g) { u32x2 o; o.x = ord2bits(key[j]); o.y = idx[j]; buf[pos] = o; } base += __builtin_popcountll(mk); }
    } else {
#pragma unroll
        for (int j = 0; j < 8; ++j) { const bool g = key[j] > T; const unsigned long long mk = __builtin_amdgcn_ballot_w64(g); const int pos = base + mbcnt64(mk);
            if (g) { u32x2 o; o.x = ord2bits(key[j]); o.y = idx[j]; buf[pos] = o; } base += __builtin_popcountll(mk); }
#pragma unroll
        for (int j = 0; j < 8; ++j) { const bool g = key[j] == T; const unsigned long long mk = __builtin_amdgcn_ballot_w64(g); const int pos = base + mbcnt64(mk);
            if (g && pos < 256) { u32x2 o; o.x = ord2bits(key[j]); o.y = idx[j]; buf[pos] = o; } base += __builtin_popcountll(mk); }
    }
    tau = __uint_as_float(ord2bits(cT == 256 ? T - 1u : T));
    LDS_WAIT();
    return base < 256 ? base : 256;
}
__device__ __forceinline__ void indexer_pair(const bf16_t* __restrict__ Z, int* __restrict__ SEL, int pair, LAS u32x2* wbuf  ) {
    const int lane = lane_id(), half = lane >> 5, r = lane & 31;
    const int tA = 2 * pair, tmine = tA + half;
    bf16x8 Af[4];
    { const int aq = tA + ((r >> 2) & 1), ah = (r >> 3) * 4 + (r & 3);
      const bf16_t* ap = Z + (size_t)aq * ZLD + OFF_QI + ah * 64 + half * 8;
#pragma unroll
      for (int kk = 0; kk < 4; ++kk) Af[kk] = *(const bf16x8*)(ap + kk * 16); }
    float wq[16];
    { const u32x4* wp = (const u32x4*)(Z + (size_t)tmine * ZLD + OFF_WI); const u32x4 a = wp[0], b = wp[1];
      wq[0] = bf_lo(a.x); wq[1] = bf_hi(a.x); wq[2] = bf_lo(a.y); wq[3] = bf_hi(a.y); wq[4] = bf_lo(a.z); wq[5] = bf_hi(a.z); wq[6] = bf_lo(a.w); wq[7] = bf_hi(a.w);
      wq[8] = bf_lo(b.x); wq[9] = bf_hi(b.x); wq[10] = bf_lo(b.y); wq[11] = bf_hi(b.y); wq[12] = bf_lo(b.z); wq[13] = bf_hi(b.z); wq[14] = bf_lo(b.w); wq[15] = bf_hi(b.w);
#pragma unroll
      for (int i = 0; i < 16; ++i) wq[i] *= 0.03125f; }
    const int nsteps = (tA + 2 + 31) >> 5;
    float tau = -__builtin_inff(); int cntA = 0, cntB = 0;
    const bf16_t* bp = Z + (size_t)r * ZLD + OFF_KI + half * 8;
    bf16x8 Bn[4];
#pragma unroll
    for (int kk = 0; kk < 4; ++kk) Bn[kk] = *(const bf16x8*)(bp + kk * 16);
#pragma unroll 1
    for (int step = 0; step < nsteps; ++step) {
        bf16x8 Bc[4];
#pragma unroll
        for (int kk = 0; kk < 4; ++kk) Bc[kk] = Bn[kk];
        if (step + 1 < nsteps) { const bf16_t* np = bp + (size_t)(step + 1) * 32 * ZLD;
#pragma unroll
            for (int kk = 0; kk < 4; ++kk) Bn[kk] = *(const bf16x8*)(np + kk * 16); }
        f32x16 acc = {0.f, 0.f, 0.f, 0.f, 0.f, 0.f, 0.f, 0.f, 0.f, 0.f, 0.f, 0.f, 0.f, 0.f, 0.f, 0.f};
#pragma unroll
        for (int kk = 0; kk < 4; ++kk) acc = __builtin_amdgcn_mfma_f32_32x32x16_bf16(Af[kk], Bc[kk], acc, 0, 0, 0);
        float sc = 0.f;
#pragma unroll
        for (int i = 0; i < 16; ++i) sc = fmaf(wq[i], fmaxf(acc[i], 0.f), sc);
        const int key = step * 32 + r;
        const bool pass = (key <= tmine) && (sc > tau);
        const unsigned long long mk = __builtin_amdgcn_ballot_w64(pass);
        if (mk != 0ull) {
            const unsigned lo = (unsigned)mk, hi = (unsigned)(mk >> 32);
            const int pre = half ? __builtin_amdgcn_mbcnt_hi(hi, 0) : __builtin_amdgcn_mbcnt_lo(lo, 0);
            const int base = half ? cntB : cntA;
            if (pass) { u32x2 o; o.x = __float_as_uint(sc); o.y = (unsigned)key; wbuf[half * 512 + base + pre] = o; }
            cntA += __builtin_popcount(lo); cntB += __builtin_popcount(hi);
            if (cntA > 480) { float nt; cntA = topk_compact(wbuf, cntA, nt); tau = half ? tau : nt; }
            if (cntB > 480) { float nt; cntB = topk_compact(wbuf + 512, cntB, nt); tau = half ? nt : tau; }
        }
    }
    if (cntA > 256) { float nt; cntA = topk_compact(wbuf, cntA, nt); }
    if (cntB > 256) { float nt; cntB = topk_compact(wbuf + 512, cntB, nt); }
    LDS_WAIT();
#pragma unroll
    for (int jj = 0; jj < 4; ++jj) { const int e = lane + 64 * jj;
        if (e < cntA) SEL[(size_t)tA * 256 + e] = (int)wbuf[e].y;
        if (e < cntB) SEL[(size_t)(tA + 1) * 256 + e] = (int)wbuf[512 + e].y; }
    LDS_WAIT();
}

__device__ __forceinline__ void indexer_block16(const bf16_t* __restrict__ Z, const bf16_t* __restrict__ KI, int* __restrict__ SEL, int qb, LAS unsigned char* lds, int wave) {
    const int lane = lane_id(), tid = wave * 64 + lane, half = lane >> 5, r = lane & 31;
    LAS u32x2* wbuf = (LAS u32x2*)lds + wave * 1024;
    LAS unsigned char* tiles = lds + 65536;
    LAS int* flags = (LAS int*)(lds + 65536 + 32768);
    const int tA = qb * 16 + wave * 2, tmine = tA + half;
    bf16x8 Af[4];
    { const int aq = tA + ((r >> 2) & 1), ah = (r >> 3) * 4 + (r & 3);
      const bf16_t* ap = Z + (size_t)aq * ZLD + OFF_QI + ah * 64 + half * 8;
#pragma unroll
      for (int kk = 0; kk < 4; ++kk) Af[kk] = *(const bf16x8*)(ap + kk * 16); }
    float wq[16];
    { const u32x4* wp = (const u32x4*)(Z + (size_t)tmine * ZLD + OFF_WI); const u32x4 a = wp[0], b = wp[1];
      wq[0] = bf_lo(a.x); wq[1] = bf_hi(a.x); wq[2] = bf_lo(a.y); wq[3] = bf_hi(a.y); wq[4] = bf_lo(a.z); wq[5] = bf_hi(a.z); wq[6] = bf_lo(a.w); wq[7] = bf_hi(a.w);
      wq[8] = bf_lo(b.x); wq[9] = bf_hi(b.x); wq[10] = bf_lo(b.y); wq[11] = bf_hi(b.y); wq[12] = bf_lo(b.z); wq[13] = bf_hi(b.z); wq[14] = bf_lo(b.w); wq[15] = bf_hi(b.w);
#pragma unroll
      for (int i = 0; i < 16; ++i) wq[i] *= 0.03125f; }
    const int ntiles = (qb * 16 + 16 + 127) >> 7;
    float tau = -__builtin_inff(); int cntA = 0, cntB = 0;
    const u32x4* gsrc = (const u32x4*)KI + tid;
    { const u32x4 g0 = gsrc[0], g1 = gsrc[512]; *(LAS u32x4*)(tiles + tid * 16) = g0; *(LAS u32x4*)(tiles + 8192 + tid * 16) = g1; }
    __syncthreads();
#pragma unroll 1
    for (int i = 0; i < ntiles; ++i) {
        u32x4 g0 = {0u, 0u, 0u, 0u}, g1 = {0u, 0u, 0u, 0u};
        const bool more = (i + 1 < ntiles);
        if (more) { g0 = gsrc[(size_t)(i + 1) * 1024]; g1 = gsrc[(size_t)(i + 1) * 1024 + 512]; }
        const LAS unsigned char* tb = tiles + (i & 1) * 16384 + lane * 16;
        float sc[4];
#pragma unroll
        for (int st = 0; st < 4; ++st) {
            bf16x8 Bc[4];
#pragma unroll
            for (int kk = 0; kk < 4; ++kk) Bc[kk] = *(const LAS bf16x8*)(tb + (st * 4 + kk) * 1024);
            f32x16 acc = {0.f, 0.f, 0.f, 0.f, 0.f, 0.f, 0.f, 0.f, 0.f, 0.f, 0.f, 0.f, 0.f, 0.f, 0.f, 0.f};
#pragma unroll
            for (int kk = 0; kk < 4; ++kk) acc = __builtin_amdgcn_mfma_f32_32x32x16_bf16(Af[kk], Bc[kk], acc, 0, 0, 0);
            float s0 = 0.f, s1 = 0.f;
#pragma unroll
            for (int h = 0; h < 16; h += 2) { const int b0 = __float_as_int(acc[h]), b1 = __float_as_int(acc[h + 1]);
                s0 = fmaf(wq[h], __int_as_float(b0 > 0 ? b0 : 0), s0); s1 = fmaf(wq[h + 1], __int_as_float(b1 > 0 ? b1 : 0), s1); }
            sc[st] = s0 + s1;
#ifdef DUP_SCORE
            { f32x16 acc2 = {0.f, 0.f, 0.f, 0.f, 0.f, 0.f, 0.f, 0.f, 0.f, 0.f, 0.f, 0.f, 0.f, 0.f, 0.f, 0.f};
#pragma unroll
              for (int kk = 0; kk < 4; ++kk) acc2 = __builtin_amdgcn_mfma_f32_32x32x16_bf16(Af[kk], Bc[3 - kk], acc2, 0, 0, 0);
              float t0 = 0.f, t1 = 0.f;
#pragma unroll
              for (int h = 0; h < 16; h += 2) { const int b0 = __float_as_int(acc2[h]), b1 = __float_as_int(acc2[h + 1]);
                  t0 = fmaf(wq[h], __int_as_float(b0 > 0 ? b0 : 0), t0); t1 = fmaf(wq[h + 1], __int_as_float(b1 > 0 ? b1 : 0), t1); }
              asm volatile("" :: "v"(t0 + t1)); }
#endif
        }
#pragma unroll
        for (int st = 0; st < 4; ++st) {
            const int key = i * 128 + st * 32 + r;
            const bool pass = (key <= tmine) && (sc[st] > tau);
            const unsigned long long mk = __builtin_amdgcn_ballot_w64(pass);
            if (mk != 0ull) {
                const unsigned lo = (unsigned)mk, hi = (unsigned)(mk >> 32);
                const int pre = half ? __builtin_amdgcn_mbcnt_hi(hi, 0) : __builtin_amdgcn_mbcnt_lo(lo, 0);
                const int base = half ? cntB : cntA;
                if (pass) { u32x2 o; o.x = __float_as_uint(sc[st]); o.y = (unsigned)key; wbuf[half * 512 + base + pre] = o; }
                cntA += __builtin_popcount(lo); cntB += __builtin_popcount(hi);
            }
        }
        if (more) { LAS unsigned char* nb = tiles + ((i + 1) & 1) * 16384; *(LAS u32x4*)(nb + tid * 16) = g0; *(LAS u32x4*)(nb + 8192 + tid * 16) = g1; }
        if (lane == 0) flags[(i & 1) * 8 + wave] = (cntA > 384 || cntB > 384) ? 1 : 0;
        __syncthreads();
        const int vote = flags[(i & 1) * 8 + (lane & 7)];
        if (__builtin_amdgcn_ballot_w64(vote != 0) != 0ull) {
            if (cntA > 256) { float nt; cntA = topk_compact(wbuf, cntA, nt); tau = half ? tau : nt; }
            if (cntB > 256) { float nt; cntB = topk_compact(wbuf + 512, cntB, nt); tau = half ? nt : tau; }
#ifdef DUP_COMPACT
            if (cntA >= 256) { float nt; cntA = topk_compact(wbuf, cntA, nt); tau = half ? tau : nt; }
            if (cntB >= 256) { float nt; cntB = topk_compact(wbuf + 512, cntB, nt); tau = half ? nt : tau; }
#endif
        }
    }
    if (cntA > 256) { float nt; cntA = topk_compact(wbuf, cntA, nt); }
    if (cntB > 256) { float nt; cntB = topk_compact(wbuf + 512, cntB, nt); }
    LDS_WAIT();
#pragma unroll
    for (int jj = 0; jj < 4; ++jj) { const int e = lane + 64 * jj;
        if (e < cntA) SEL[(size_t)tA * 256 + e] = (int)wbuf[e].y;
        if (e < cntB) SEL[(size_t)(tA + 1) * 256 + e] = (int)wbuf[512 + e].y; }
    __syncthreads();
}

__device__ __forceinline__ void attn_query(const bf16_t* __restrict__ Z, const int* __restrict__ SEL, bf16_t* __restrict__ YMIX, int t, LAS float* sbuf  ) {
    const int lane = lane_id(), hq = lane >> 4;
    const int nsel = (t + 1 < 256) ? (t + 1) : 256;
    int iv[4];
#pragma unroll
    for (int jj = 0; jj < 4; ++jj) { const int e = lane + 64 * jj; iv[jj] = (e < nsel) ? SEL[(size_t)t * 256 + e] : 0; }
    const bf16_t* qp = Z + (size_t)t * ZLD + OFF_Q + lane * 8;
    const u32x4 qa = *(const u32x4*)qp, qb = *(const u32x4*)(qp + 512);
#pragma unroll
    for (int jj = 0; jj < 4; ++jj) {
        if (jj * 64 < nsel) {
#pragma unroll 1
            for (int l0 = 0; l0 < 64; l0 += 8) {
                const int j0 = jj * 64 + l0; if (j0 >= nsel) break;
                u32x4 ka[8], kb[8];
#pragma unroll
                for (int u = 0; u < 8; ++u) { const int si = __builtin_amdgcn_readlane(iv[jj], l0 + u); const bf16_t* kp = Z + (size_t)si * ZLD + OFF_K + lane * 8; ka[u] = *(const u32x4*)kp; kb[u] = *(const u32x4*)(kp + 512); }
#pragma unroll
                for (int u = 0; u < 8; ++u) { float da = dot8(qa, ka[u]), db = dot8(qb, kb[u]);
                    da = red16(da); db = red16(db);
                    if ((lane & 15) == 0) { sbuf[hq * 256 + j0 + u] = da; sbuf[(4 + hq) * 256 + j0 + u] = db; } }
            }
        }
    }
    LDS_WAIT();
#pragma unroll 1
    for (int h = 0; h < 8; ++h) {
        float sv[4]; float mx = -__builtin_inff();
#pragma unroll
        for (int jj = 0; jj < 4; ++jj) { const int j = lane + 64 * jj; const float s = sbuf[h * 256 + j]; sv[jj] = (j < nsel) ? s : -__builtin_inff(); mx = fmaxf(mx, sv[jj]); }
        mx = wave_max(mx); float sm = 0.f;
#pragma unroll
        for (int jj = 0; jj < 4; ++jj) { const int j = lane + 64 * jj; sv[jj] = (j < nsel) ? __expf(sv[jj] - mx) : 0.f; sm += sv[jj]; }
        sm = wave_sum(sm); const float inv = 1.f / sm;
#pragma unroll
        for (int jj = 0; jj < 4; ++jj) sbuf[h * 256 + lane + 64 * jj] = sv[jj] * inv;
    }
    LDS_WAIT();
    float oa[8], ob[8];
#pragma unroll
    for (int i = 0; i < 8; ++i) { oa[i] = 0.f; ob[i] = 0.f; }
#pragma unroll
    for (int jj = 0; jj < 4; ++jj) {
        if (jj * 64 < nsel) {
#pragma unroll 1
            for (int l0 = 0; l0 < 64; l0 += 8) {
                const int j0 = jj * 64 + l0; if (j0 >= nsel) break;
                u32x4 va[8], vb[8];
#pragma unroll
                for (int u = 0; u < 8; ++u) { const int si = __builtin_amdgcn_readlane(iv[jj], l0 + u); const bf16_t* vp = Z + (size_t)si * ZLD + OFF_V + lane * 8; va[u] = *(const u32x4*)vp; vb[u] = *(const u32x4*)(vp + 512); }
                const LAS f32x4* pa4 = (const LAS f32x4*)(sbuf + hq * 256 + j0); const LAS f32x4* pb4 = (const LAS f32x4*)(sbuf + (4 + hq) * 256 + j0);
                const f32x4 pa0 = pa4[0], pa1 = pa4[1], pb0 = pb4[0], pb1 = pb4[1];
                const float pa[8] = {pa0.x, pa0.y, pa0.z, pa0.w, pa1.x, pa1.y, pa1.z, pa1.w}, pb[8] = {pb0.x, pb0.y, pb0.z, pb0.w, pb1.x, pb1.y, pb1.z, pb1.w};
#pragma unroll
                for (int u = 0; u < 8; ++u) {
                    oa[0] = fmaf(pa[u], bf_lo(va[u].x), oa[0]); oa[1] = fmaf(pa[u], bf_hi(va[u].x), oa[1]); oa[2] = fmaf(pa[u], bf_lo(va[u].y), oa[2]); oa[3] = fmaf(pa[u], bf_hi(va[u].y), oa[3]);
                    oa[4] = fmaf(pa[u], bf_lo(va[u].z), oa[4]); oa[5] = fmaf(pa[u], bf_hi(va[u].z), oa[5]); oa[6] = fmaf(pa[u], bf_lo(va[u].w), oa[6]); oa[7] = fmaf(pa[u], bf_hi(va[u].w), oa[7]);
                    ob[0] = fmaf(pb[u], bf_lo(vb[u].x), ob[0]); ob[1] = fmaf(pb[u], bf_hi(vb[u].x), ob[1]); ob[2] = fmaf(pb[u], bf_lo(vb[u].y), ob[2]); ob[3] = fmaf(pb[u], bf_hi(vb[u].y), ob[3]);
                    ob[4] = fmaf(pb[u], bf_lo(vb[u].z), ob[4]); ob[5] = fmaf(pb[u], bf_hi(vb[u].z), ob[5]); ob[6] = fmaf(pb[u], bf_lo(vb[u].w), ob[6]); ob[7] = fmaf(pb[u], bf_hi(vb[u].w), ob[7]);
                }
            }
        }
    }
    u32x4 o0, o1;
    o0.x = cvt_pk_bf16(oa[0], oa[1]); o0.y = cvt_pk_bf16(oa[2], oa[3]); o0.z = cvt_pk_bf16(oa[4], oa[5]); o0.w = cvt_pk_bf16(oa[6], oa[7]);
    o1.x = cvt_pk_bf16(ob[0], ob[1]); o1.y = cvt_pk_bf16(ob[2], ob[3]); o1.z = cvt_pk_bf16(ob[4], ob[5]); o1.w = cvt_pk_bf16(ob[6], ob[7]);
    bf16_t* yp = YMIX + (size_t)t * D_ + 1024 + lane * 8;
    *(u32x4*)yp = o0; *(u32x4*)(yp + 512) = o1;
    LDS_WAIT();
}


typedef float f32x2v __attribute__((ext_vector_type(2)));
__device__ __forceinline__ float red8(float v) { v += dpp_f<0xB1>(v); v += dpp_f<0x4E>(v); v += dpp_f<0x141>(v); return v; }
#ifndef KV8_AUX
#define KV8_AUX 1
#endif
__device__ __forceinline__ void kv8_issue(u32x4 (&buf)[8], __amdgpu_buffer_rsrc_t rs, int voff  , int sbase  , const int (&iv)[4], int b) {
    const int jj = b >> 3, l0 = (b & 7) * 8;
    const int ivb = (jj == 0) ? iv[0] : (jj == 1) ? iv[1] : (jj == 2) ? iv[2] : iv[3];
#pragma unroll
    for (int u = 0; u < 8; ++u) { const int si = __builtin_amdgcn_readlane(ivb, l0 + u); buf[u] = __builtin_amdgcn_raw_buffer_load_b128(rs, voff, si * 2048 + sbase, KV8_AUX); }
}
__device__ __forceinline__ void kv8_qk(const u32x4 (&buf)[8], const f32x2v (&q2)[8], LAS float* srow, int b, int lane) {
#pragma unroll
    for (int u = 0; u < 8; ++u) {
        const u32x4 k = buf[u];
        f32x2v s0 = q2[0] * __builtin_amdgcn_cvt_pk_f32_fp8(k.x, false), s1 = q2[1] * __builtin_amdgcn_cvt_pk_f32_fp8(k.x, true);
        s0 = __builtin_elementwise_fma(q2[2], __builtin_amdgcn_cvt_pk_f32_fp8(k.y, false), s0); s1 = __builtin_elementwise_fma(q2[3], __builtin_amdgcn_cvt_pk_f32_fp8(k.y, true), s1);
        s0 = __builtin_elementwise_fma(q2[4], __builtin_amdgcn_cvt_pk_f32_fp8(k.z, false), s0); s1 = __builtin_elementwise_fma(q2[5], __builtin_amdgcn_cvt_pk_f32_fp8(k.z, true), s1);
        s0 = __builtin_elementwise_fma(q2[6], __builtin_amdgcn_cvt_pk_f32_fp8(k.w, false), s0); s1 = __builtin_elementwise_fma(q2[7], __builtin_amdgcn_cvt_pk_f32_fp8(k.w, true), s1);
        const f32x2v t = s0 + s1;
        const float s = red8(t.x + t.y);
        if ((lane & 7) == 0) srow[b * 8 + u] = s;
    }
}
__device__ __forceinline__ void kv8_pv(const u32x4 (&buf)[8], f32x2v (&o2)[8], const LAS float* srow, int b) {
    const LAS f32x4* p4 = (const LAS f32x4*)(srow + b * 8);
    const f32x4 p0 = p4[0], p1 = p4[1];
    const float p[8] = {p0.x, p0.y, p0.z, p0.w, p1.x, p1.y, p1.z, p1.w};
#pragma unroll
    for (int u = 0; u < 8; ++u) {
        const u32x4 v = buf[u]; const f32x2v pp = {p[u], p[u]};
        o2[0] = __builtin_elementwise_fma(pp, __builtin_amdgcn_cvt_pk_f32_fp8(v.x, false), o2[0]); o2[1] = __builtin_elementwise_fma(pp, __builtin_amdgcn_cvt_pk_f32_fp8(v.x, true), o2[1]);
        o2[2] = __builtin_elementwise_fma(pp, __builtin_amdgcn_cvt_pk_f32_fp8(v.y, false), o2[2]); o2[3] = __builtin_elementwise_fma(pp, __builtin_amdgcn_cvt_pk_f32_fp8(v.y, true), o2[3]);
        o2[4] = __builtin_elementwise_fma(pp, __builtin_amdgcn_cvt_pk_f32_fp8(v.z, false), o2[4]); o2[5] = __builtin_elementwise_fma(pp, __builtin_amdgcn_cvt_pk_f32_fp8(v.z, true), o2[5]);
        o2[6] = __builtin_elementwise_fma(pp, __builtin_amdgcn_cvt_pk_f32_fp8(v.w, false), o2[6]); o2[7] = __builtin_elementwise_fma(pp, __builtin_amdgcn_cvt_pk_f32_fp8(v.w, true), o2[7]);
    }
}
__device__ __forceinline__ void attn_query8(const unsigned char* __restrict__ KV8, const bf16_t* __restrict__ Z, const int* __restrict__ SEL, bf16_t* __restrict__ YMIX, int t, LAS float* sbuf  ) {
    const int lane = lane_id(), hd = lane >> 3;
    const int nsel = (t + 1 < 256) ? (t + 1) : 256, nb = (nsel + 7) >> 3;
    int iv[4];
#pragma unroll
    for (int jj = 0; jj < 4; ++jj) { const int e = lane + 64 * jj; iv[jj] = (e < nsel) ? SEL[(size_t)t * 256 + e] : 0; }
    f32x2v qf[8];
    { const u32x4* qp = (const u32x4*)(Z + (size_t)t * ZLD + OFF_Q + lane * 16); const u32x4 a = qp[0], b = qp[1];
      qf[0] = (f32x2v){bf_lo(a.x), bf_hi(a.x)}; qf[1] = (f32x2v){bf_lo(a.y), bf_hi(a.y)}; qf[2] = (f32x2v){bf_lo(a.z), bf_hi(a.z)}; qf[3] = (f32x2v){bf_lo(a.w), bf_hi(a.w)};
      qf[4] = (f32x2v){bf_lo(b.x), bf_hi(b.x)}; qf[5] = (f32x2v){bf_lo(b.y), bf_hi(b.y)}; qf[6] = (f32x2v){bf_lo(b.z), bf_hi(b.z)}; qf[7] = (f32x2v){bf_lo(b.w), bf_hi(b.w)}; }
    const __amdgpu_buffer_rsrc_t rs = __builtin_amdgcn_make_buffer_rsrc((void*)KV8, 0, 0x7fffffff, 0x00020000);
    const int lvo = lane * 16;
    LAS float* srow = sbuf + hd * 256;
    u32x4 A[8], B[8], C[8];
    const int lb = nb - 1;
#define CLAMPB(x) ((x) < lb ? (x) : lb)
    kv8_issue(A, rs, lvo, 0, iv, 0);
    kv8_issue(B, rs, lvo, 0, iv, CLAMPB(1));
#pragma unroll 1
    for (int b = 0; b < nb; b += 3) {
        kv8_issue(C, rs, lvo, 0, iv, CLAMPB(b + 2));
        kv8_qk(A, qf, srow, b, lane);
        kv8_issue(A, rs, lvo, 0, iv, CLAMPB(b + 3));
        if (b + 1 < nb) kv8_qk(B, qf, srow, b + 1, lane);
        kv8_issue(B, rs, lvo, 0, iv, CLAMPB(b + 4));
        if (b + 2 < nb) kv8_qk(C, qf, srow, b + 2, lane);
    }
    kv8_issue(A, rs, lvo, 1024, iv, 0);
    kv8_issue(B, rs, lvo, 1024, iv, CLAMPB(1));
    LDS_WAIT();
#pragma unroll 1
    for (int h = 0; h < 8; ++h) {
        float sv[4]; float mx = -__builtin_inff();
#pragma unroll
        for (int jj = 0; jj < 4; ++jj) { const int j = lane + 64 * jj; const float s = sbuf[h * 256 + j]; sv[jj] = (j < nsel) ? s : -__builtin_inff(); mx = fmaxf(mx, sv[jj]); }
        mx = wave_max(mx); float sm = 0.f;
#pragma unroll
        for (int jj = 0; jj < 4; ++jj) { const int j = lane + 64 * jj; sv[jj] = (j < nsel) ? __expf(sv[jj] - mx) : 0.f; sm += sv[jj]; }
        sm = wave_sum(sm); const float inv = 1.f / sm;
#pragma unroll
        for (int jj = 0; jj < 4; ++jj) sbuf[h * 256 + lane + 64 * jj] = sv[jj] * inv;
    }
    LDS_WAIT();
    f32x2v o[8];
#pragma unroll
    for (int i = 0; i < 8; ++i) o[i] = (f32x2v){0.f, 0.f};
#pragma unroll 1
    for (int b = 0; b < nb; b += 3) {
        kv8_issue(C, rs, lvo, 1024, iv, CLAMPB(b + 2));
        kv8_pv(A, o, srow, b);
        kv8_issue(A, rs, lvo, 1024, iv, CLAMPB(b + 3));
        if (b + 1 < nb) kv8_pv(B, o, srow, b + 1);
        kv8_issue(B, rs, lvo, 1024, iv, CLAMPB(b + 4));
        if (b + 2 < nb) kv8_pv(C, o, srow, b + 2);
    }
#undef CLAMPB
    u32x4 o0, o1;
    o0.x = cvt_pk_bf16(o[0].x, o[0].y); o0.y = cvt_pk_bf16(o[1].x, o[1].y); o0.z = cvt_pk_bf16(o[2].x, o[2].y); o0.w = cvt_pk_bf16(o[3].x, o[3].y);
    o1.x = cvt_pk_bf16(o[4].x, o[4].y); o1.y = cvt_pk_bf16(o[5].x, o[5].y); o1.z = cvt_pk_bf16(o[6].x, o[6].y); o1.w = cvt_pk_bf16(o[7].x, o[7].y);
    u32x4* yp = (u32x4*)(YMIX + (size_t)t * D_ + 1024 + lane * 16);
    yp[0] = o0; yp[1] = o1;
    LDS_WAIT();
}

#define XB_TMO      128
#define XB_XCNT(j)  (256  + 64 * (j))
#define XB_XSUB(j)  (1280 + 64 * (j))
#define XB_XGEN(j)  (2304 + 64 * (j))
#define XB_TOP      3328
#define XB_TOPGEN   3392
#define XB_SPIN_CAP (1u << 23)
__device__ __forceinline__ unsigned xb_ld(unsigned* p)              { return __hip_atomic_load(p, __ATOMIC_RELAXED, __HIP_MEMORY_SCOPE_AGENT); }
__device__ __forceinline__ unsigned xb_add(unsigned* p, unsigned v) { return __hip_atomic_fetch_add(p, v, __ATOMIC_RELAXED, __HIP_MEMORY_SCOPE_AGENT); }
__device__ __forceinline__ unsigned xb_xcc_id() { return (unsigned)__builtin_amdgcn_s_getreg((3 << 11) | 20) & 0xFu; }
#define XB_SPIN(cond, bar) do { unsigned _sp = 0; while (cond) { __builtin_amdgcn_s_sleep(1); \
    if ((++_sp & 255u) == 0u) { if (xb_ld(&(bar)[XB_TMO])) break; if (_sp > XB_SPIN_CAP) { atomicAdd(&(bar)[XB_TMO], 1u); break; } } } } while (0)
__device__ __forceinline__ void xcd_barrier_complete(unsigned* bar, unsigned x, unsigned& nloc, unsigned& nx) {
    const unsigned G = gridDim.x * gridDim.y * gridDim.z;
    unsigned sum, cnt, mine, sp = 0u;
    for (;;) {
        sum = 0u; cnt = 0u; mine = 0u;
#pragma unroll
        for (unsigned j = 0; j < 16; ++j) { const unsigned c = xb_ld(&bar[XB_XCNT(j)]); sum += c; cnt += (c > 0u) ? 1u : 0u; mine = (j == x) ? c : mine; }
        if (sum == G) break;
        __builtin_amdgcn_s_sleep(1);
        if ((++sp & 255u) == 0u) { if (xb_ld(&bar[XB_TMO])) break; if (sp > XB_SPIN_CAP) { atomicAdd(&bar[XB_TMO], 1u); break; } }
    }
    nloc = mine > 0u ? mine : 1u; nx = cnt > 0u ? cnt : 1u;
}
__device__ __forceinline__ void xcd_barrier(unsigned* bar, volatile LAS unsigned* st, bool leader) {
    asm volatile("s_waitcnt vmcnt(0)" ::: "memory");
    __syncthreads();
    if (leader) {
        __builtin_amdgcn_s_waitcnt(0);
        const unsigned x = xb_xcc_id();
        unsigned nloc = st[0], nx = st[1];
        if (nloc == 0u) { xcd_barrier_complete(bar, x, nloc, nx); st[0] = nloc; st[1] = nx; }
        const unsigned old = xb_add(&bar[XB_XSUB(x)], 1u);
        const unsigned gen = old / nloc;
        if (old + 1u == (gen + 1u) * nloc) {
            __builtin_amdgcn_fence(__ATOMIC_RELEASE, "agent");
            asm volatile("s_waitcnt vmcnt(0)" ::: "memory");
            const unsigned og = xb_add(&bar[XB_TOP], 1u);
            const unsigned tg = og / nx;
            if (og + 1u == (tg + 1u) * nx) xb_add(&bar[XB_TOPGEN], 1u);
            else XB_SPIN(xb_ld(&bar[XB_TOPGEN]) == tg, bar);
            __builtin_amdgcn_fence(__ATOMIC_ACQUIRE, "agent");
            xb_add(&bar[XB_XGEN(x)], 1u);
            asm volatile("s_waitcnt vmcnt(0)" ::: "memory");
        } else {
            XB_SPIN(xb_ld(&bar[XB_XGEN(x)]) == gen, bar);
            __builtin_amdgcn_fence(__ATOMIC_ACQUIRE, "agent");
            asm volatile("s_waitcnt vmcnt(0)" ::: "memory");
        }
    }
    __syncthreads();
}

__global__ void __launch_bounds__(512, 2) mega(Params p) {
    extern __shared__ __attribute__((aligned(16))) unsigned char smem[];
    cg::grid_group grid = cg::this_grid();
    LAS unsigned char* lds = (LAS unsigned char*)smem;
    const int wave = __builtin_amdgcn_readfirstlane((int)threadIdx.x >> 6);
    const int nblk = gridDim.x, bid = blockIdx.x, gw = bid * 8 + wave, ngw = nblk * 8;
#define PHASE_IDS() const int lane = lane_id(), tid = wave * 64 + lane; (void)tid; (void)lane
    const float* x = p.in[0]; const float* attn_g = p.in[1]; const float* w_in = p.in[2]; const float* pool_w = p.in[3]; const float* pool_scale = p.in[4];
    const float* qn_g = p.in[5]; const float* kn_g = p.in[6]; const float* w_out = p.in[7]; const float* ffn_g = p.in[8]; const float* w_up = p.in[9];
    const float* conv_w = p.in[10]; const float* conv_b = p.in[11]; const float* w_down = p.in[12];
    bf16_t* WinT = (bf16_t*)(p.ws + WS_WIN); bf16_t* WoutT = (bf16_t*)(p.ws + WS_WOUT); bf16_t* WupT = (bf16_t*)(p.ws + WS_WUP); bf16_t* WdT = (bf16_t*)(p.ws + WS_WDN);
    bf16_t* PwT = (bf16_t*)(p.ws + WS_PW); bf16_t* Hb = (bf16_t*)(p.ws + WS_H); bf16_t* H = Hb + 2 * D_; bf16_t* Z = (bf16_t*)(p.ws + WS_Z);
    bf16_t* YMIX = (bf16_t*)(p.ws + WS_YMIX); bf16_t* Dp = (bf16_t*)(p.ws + WS_DP); int* SEL = (int*)(p.ws + WS_SEL); bf16_t* ACT = (bf16_t*)(p.ws + WS_ACT); unsigned char* KV8 = p.ws + WS_KV8; bf16_t* KI = (bf16_t*)(p.ws + WS_KI);
    float* out = p.out;
    unsigned* gbar = (unsigned*)(p.ws + WS_BAR); volatile LAS unsigned* gst = (volatile LAS unsigned*)(lds + LDS_BARST);
    { const bool ld0 = (wave == 0) && (lane_id() == 0);
      if (ld0) { gst[0] = 0u; gst[1] = 0u; (void)xb_add(&gbar[XB_XCNT(xb_xcc_id())], 1u); } }
#define GRID_BAR() xcd_barrier(gbar, gst, (wave == 0) && (lane_id() == 0))

#ifdef DUP_P0
    for (int rep0 = 0; rep0 < 2; ++rep0)
#endif
    {
        PHASE_IDS();
        LAS float* scr = (LAS float*)lds + wave * (64 * 65);
        constexpr int NB_IN = ZLD / 64, NB_UP = 2 * DFF / 64;
        constexpr int I_IN = 32 * NB_IN, I_OUT = 32 * 32, I_UP = 32 * NB_UP, I_DN = (DFF / 64) * 32, I_PW = 4 * 4 * 4;
        constexpr int NITEMS = I_IN + I_OUT + I_UP + I_DN + I_PW;
        for (int it = gw; it < NITEMS; it += ngw) {
            int r = it;
            if (r < I_IN) { const int nb = r % NB_IN, kb = r / NB_IN, n0 = nb * 64; int nv = DIN - n0; nv = nv < 0 ? 0 : (nv > 64 ? 64 : nv);
                transpose_item(w_in, DIN, n0, nv, WinT, D_, n0, kb * 64, nullptr, scr, lane); continue; }
            r -= I_IN;
            if (r < I_OUT) { const int nb = r % 32, kb = r / 32; transpose_item(w_out, D_, nb * 64, 64, WoutT, D_, nb * 64, kb * 64, nullptr, scr, lane); continue; }
            r -= I_OUT;
            if (r < I_UP) { const int nb = r % NB_UP, kb = r / NB_UP, n0 = nb * 64, tile = n0 >> 8, j = n0 & 255;
                const int src = (j < 128) ? (128 * tile + j) : (DFF + 128 * tile + (j - 128));
                transpose_item(w_up, 2 * DFF, src, 64, WupT, D_, n0, kb * 64, nullptr, scr, lane); continue; }
            r -= I_UP;
            if (r < I_DN) { const int nb = r % 32, kb = r / 32; transpose_item(w_down, D_, nb * 64, 64, WdT, DFF, nb * 64, kb * 64, nullptr, scr, lane); continue; }
            r -= I_DN;
            { const int g = r >> 4, rr = r & 15, nb = rr & 3, kb = rr >> 2;
              transpose_item(pool_w + (size_t)g * 65536, 256, nb * 64, 64, PwT + (size_t)g * 65536, 256, nb * 64, kb * 64, pool_scale + g * 256, scr, lane); }
        }
        for (int row = gw; row < S_; row += ngw) rmsnorm_row(x + (size_t)row * D_, attn_g, H + (size_t)row * D_, lane);
    }
    if (nblk == 0x7fffffff) grid.sync();
    GRID_BAR();
    {
        pg8::Gemm g{H, WinT, S_, ZLD, D_, (size_t)256 * D_ * 2}; pg8::StaticOrder S; S.init(S_, ZLD, nblk, bid); EpiStoreBf16 E{Z, ZLD, KI};
#ifndef SKIP_G1
        pg8::gemm_phase<EpiStoreBf16, pg8::StaticOrder, true, true>(lds, g, S, E, wave);
#endif
#ifdef DUP_G1
        pg8::gemm_phase<EpiStoreBf16, pg8::StaticOrder, true, true>(lds, g, S, E, wave);
#endif
    }
    GRID_BAR();
    {
        PHASE_IDS();
#pragma unroll 1
        for (int step2 = 0; step2 < 2; ++step2) {
        if ((step2 ^ (bid & 1)) == 0) {
#ifdef DUP_P2A
        for (int rep2 = 0; rep2 < 2; ++rep2)
#endif
        for (size_t it = (size_t)bid * 512 + tid; it < (size_t)S_ * 128; it += (size_t)nblk * 512) {
            const int t = (int)(it >> 7), c = ((int)it & 127) * 8, g = c >> 8, w = 2 << g;
            const int lo = (t + 1 - w) > 0 ? (t + 1 - w) : 0; const float inv = 1.f / (float)(t + 1 - lo);
            float s[8] = {0.f, 0.f, 0.f, 0.f, 0.f, 0.f, 0.f, 0.f}; u32x4 v = {0u, 0u, 0u, 0u};
            for (int tt = lo; tt <= t; ++tt) { v = *(const u32x4*)(Z + (size_t)tt * ZLD + c);
                s[0] += bf_lo(v.x); s[1] += bf_hi(v.x); s[2] += bf_lo(v.y); s[3] += bf_hi(v.y); s[4] += bf_lo(v.z); s[5] += bf_hi(v.z); s[6] += bf_lo(v.w); s[7] += bf_hi(v.w); }
            u32x4 o; o.x = cvt_pk_bf16(s[0] * inv - bf_lo(v.x), s[1] * inv - bf_hi(v.x)); o.y = cvt_pk_bf16(s[2] * inv - bf_lo(v.y), s[3] * inv - bf_hi(v.y));
            o.z = cvt_pk_bf16(s[4] * inv - bf_lo(v.z), s[5] * inv - bf_hi(v.z)); o.w = cvt_pk_bf16(s[6] * inv - bf_lo(v.w), s[7] * inv - bf_hi(v.w));
            *(u32x4*)(Dp + ((size_t)g * S_ + t) * 256 + (c & 255)) = o;
        }
        {
            const int d0 = (lane & 7) * 16;
            float gq[16];
#pragma unroll
            for (int e = 0; e < 16; ++e) gq[e] = qn_g[d0 + e] * kn_g[d0 + e] * 0.08838834764831845f;
            for (int t = gw; t < S_; t += ngw) {
#pragma unroll
                for (int which = 0; which < 2; ++which) {
                    u32x4* ptr = (u32x4*)(Z + (size_t)t * ZLD + (which ? OFF_K : OFF_Q) + lane * 16);
                    const u32x4 a = ptr[0], b = ptr[1];
                    float f[16] = {bf_lo(a.x), bf_hi(a.x), bf_lo(a.y), bf_hi(a.y), bf_lo(a.z), bf_hi(a.z), bf_lo(a.w), bf_hi(a.w), bf_lo(b.x), bf_hi(b.x), bf_lo(b.y), bf_hi(b.y), bf_lo(b.z), bf_hi(b.z), bf_lo(b.w), bf_hi(b.w)};
                    float ss = 0.f;
#pragma unroll
                    for (int e = 0; e < 16; ++e) ss = fmaf(f[e], f[e], ss);
                    ss += __shfl_xor(ss, 1); ss += __shfl_xor(ss, 2); ss += __shfl_xor(ss, 4);
                    const float rinv = 1.f / sqrtf(ss * (1.f / 128.f) + EPS_);
#pragma unroll
                    for (int e = 0; e < 16; ++e) f[e] = f[e] * rinv * (which ? 1.f : gq[e]);
                    if (which == 0) {
                        u32x4 oa, ob; oa.x = cvt_pk_bf16(f[0], f[1]); oa.y = cvt_pk_bf16(f[2], f[3]); oa.z = cvt_pk_bf16(f[4], f[5]); oa.w = cvt_pk_bf16(f[6], f[7]);
                        ob.x = cvt_pk_bf16(f[8], f[9]); ob.y = cvt_pk_bf16(f[10], f[11]); ob.z = cvt_pk_bf16(f[12], f[13]); ob.w = cvt_pk_bf16(f[14], f[15]);
                        ptr[0] = oa; ptr[1] = ob;
                    } else {
                        int w0 = 0, w1 = 0, w2 = 0, w3 = 0;
                        w0 = __builtin_amdgcn_cvt_pk_fp8_f32(f[0], f[1], w0, false); w0 = __builtin_amdgcn_cvt_pk_fp8_f32(f[2], f[3], w0, true);
                        w1 = __builtin_amdgcn_cvt_pk_fp8_f32(f[4], f[5], w1, false); w1 = __builtin_amdgcn_cvt_pk_fp8_f32(f[6], f[7], w1, true);
                        w2 = __builtin_amdgcn_cvt_pk_fp8_f32(f[8], f[9], w2, false); w2 = __builtin_amdgcn_cvt_pk_fp8_f32(f[10], f[11], w2, true);
                        w3 = __builtin_amdgcn_cvt_pk_fp8_f32(f[12], f[13], w3, false); w3 = __builtin_amdgcn_cvt_pk_fp8_f32(f[14], f[15], w3, true);
                        u32x4 o8; o8.x = (unsigned)w0; o8.y = (unsigned)w1; o8.z = (unsigned)w2; o8.w = (unsigned)w3;
                        *(u32x4*)(KV8 + (size_t)t * 2048 + lane * 16) = o8;
                    }
                }
                {
                    const u32x4* ptr = (const u32x4*)(Z + (size_t)t * ZLD + OFF_V + lane * 16);
                    const u32x4 a = ptr[0], b = ptr[1];
                    int w0 = 0, w1 = 0, w2 = 0, w3 = 0;
                    w0 = __builtin_amdgcn_cvt_pk_fp8_f32(bf_lo(a.x), bf_hi(a.x), w0, false); w0 = __builtin_amdgcn_cvt_pk_fp8_f32(bf_lo(a.y), bf_hi(a.y), w0, true);
                    w1 = __builtin_amdgcn_cvt_pk_fp8_f32(bf_lo(a.z), bf_hi(a.z), w1, false); w1 = __builtin_amdgcn_cvt_pk_fp8_f32(bf_lo(a.w), bf_hi(a.w), w1, true);
                    w2 = __builtin_amdgcn_cvt_pk_fp8_f32(bf_lo(b.x), bf_hi(b.x), w2, false); w2 = __builtin_amdgcn_cvt_pk_fp8_f32(bf_lo(b.y), bf_hi(b.y), w2, true);
                    w3 = __builtin_amdgcn_cvt_pk_fp8_f32(bf_lo(b.z), bf_hi(b.z), w3, false); w3 = __builtin_amdgcn_cvt_pk_fp8_f32(bf_lo(b.w), bf_hi(b.w), w3, true);
                    u32x4 o8; o8.x = (unsigned)w0; o8.y = (unsigned)w1; o8.z = (unsigned)w2; o8.w = (unsigned)w3;
                    *(u32x4*)(KV8 + (size_t)t * 2048 + 1024 + lane * 16) = o8;
                }
            }
        }
        } else {
        {
            __syncthreads();
#ifdef DUP_IDX
            for (int rep = 0; rep < 2; ++rep)
#endif
            for (int base = 0; base < 512; base += nblk) {
                const int i = base + bid;
                if (i < 512) {
#ifndef SKIP_IDX
                    indexer_block16(Z, KI, SEL, i, lds, wave);
                    indexer_block16(Z, KI, SEL, 1023 - i, lds, wave);
#endif
                }
            }
        }
        }
        }
    }
    GRID_BAR();
    {
        int kpool = 256; asm volatile("" : "+s"(kpool));
        pg8::Gemm g{Dp, PwT, 4 * S_, 1024, kpool, (size_t)256 * 256 * 2}; PoolOrder S{nblk, bid}; EpiPool E{YMIX};
#ifndef SKIP_G3
        pg8::gemm_phase<EpiPool, PoolOrder, true, true>(lds, g, S, E, wave);
#endif
        __syncthreads();
        LAS float* sbuf = (LAS float*)lds + wave * 2048;
#ifndef SKIP_ATT
        for (int t = gw; t < S_; t += ngw) attn_query8(KV8, Z, SEL, YMIX, t, sbuf);
#endif
#ifdef DUP_ATT
        for (int t = gw; t < S_; t += ngw) attn_query8(KV8, Z, SEL, YMIX, t, sbuf);
#endif
    }
    GRID_BAR();
    {
        pg8::Gemm g{YMIX, WoutT, S_, D_, D_, (size_t)256 * D_ * 2}; pg8::StaticOrder S; S.init(S_, D_, nblk, bid); EpiResid E{x, out};
#ifndef SKIP_G4
        pg8::gemm_phase<EpiResid, pg8::StaticOrder, true, true>(lds, g, S, E, wave);
#endif
#ifdef DUP_G4
        pg8::gemm_phase<EpiResid, pg8::StaticOrder, true, true>(lds, g, S, E, wave);
#endif
    }
    GRID_BAR();
    {
        PHASE_IDS();
#ifdef DUP_P5
        for (int rep5 = 0; rep5 < 2; ++rep5)
#endif
        for (int row = gw; row < S_; row += ngw) rmsnorm_row(out + (size_t)row * D_, ffn_g, H + (size_t)row * D_, lane);
        if (bid == 0) { u32x4 z = {0u, 0u, 0u, 0u};
            for (int i = tid; i < 2 * D_ / 8; i += 512) ((u32x4*)Hb)[i] = z;
            for (int i = tid; i < 126 * D_ / 8; i += 512) ((u32x4*)(H + (size_t)S_ * D_))[i] = z; }
    }
    GRID_BAR();
    {
        pg8::Gemm g{Hb, WupT, UP_TILES * 256, 2 * DFF, D_, (size_t)UP_ROWS * D_ * 2}; pg8::StaticOrder S; S.init(UP_TILES * 256, 2 * DFF, nblk, bid);
        EpiUp E{ACT, conv_w, conv_b, (LAS f32x4*)(lds + LDS_XL)};
#ifndef SKIP_G6
        pg8::gemm_phase<EpiUp, pg8::StaticOrder, true, true>(lds, g, S, E, wave);
#endif
#ifdef DUP_G6
        pg8::gemm_phase<EpiUp, pg8::StaticOrder, true, true>(lds, g, S, E, wave);
#endif
    }
    GRID_BAR();
    {
        pg8::Gemm g{ACT, WdT, S_, D_, DFF, (size_t)256 * DFF * 2}; pg8::StaticOrder S; S.init(S_, D_, nblk, bid); EpiResid E{out, out};
#ifndef SKIP_G7
        pg8::gemm_phase<EpiResid, pg8::StaticOrder, true, true>(lds, g, S, E, wave);
#endif
    }
}

extern "C" void kernel_launch(void* const* d_in, const int* in_sizes, int n_in, void* d_out, int out_size, void* d_ws, size_t ws_size, hipStream_t stream) {
    static int grid = 0;
    if (grid == 0) {
        if (n_in != 13 || in_sizes[0] != S_ * D_ || out_size != S_ * D_ || ws_size < WS_END) { fprintf(stderr, "kernel_launch: unexpected shapes (n_in %d, ws %zu, need %zu)\n", n_in, ws_size, (size_t)WS_END); grid = -1; return; }
        int dev = 0, cus = 0, per_cu = 0;
        if (hipGetDevice(&dev) != hipSuccess || hipDeviceGetAttribute(&cus, hipDeviceAttributeMultiprocessorCount, dev) != hipSuccess) { grid = -1; return; }
        if (hipFuncSetAttribute((const void*)mega, hipFuncAttributeMaxDynamicSharedMemorySize, LDS_BYTES) != hipSuccess) { fprintf(stderr, "kernel_launch: hipFuncSetAttribute failed\n"); grid = -1; return; }
        if (hipOccupancyMaxActiveBlocksPerMultiprocessor(&per_cu, (const void*)mega, 512, LDS_BYTES) != hipSuccess || per_cu < 1) { fprintf(stderr, "kernel_launch: occupancy query failed (%d)\n", per_cu); (void)hipGetLastError(); per_cu = 1; }
        grid = cus * per_cu;
    }
    if (grid < 0) return;
    Params p{};
    for (int i = 0; i < 13; ++i) p.in[i] = (const float*)d_in[i];
    p.out = (float*)d_out; p.ws = (unsigned char*)d_ws;
    if (hipMemsetAsync((char*)d_ws + WS_BAR, 0, 16384, stream) != hipSuccess) { fprintf(stderr, "kernel_launch: memset of the barrier words failed\n"); return; }
    void* args[] = {&p};
    const hipError_t e = hipLaunchCooperativeKernel((const void*)mega, dim3(grid), dim3(512), args, LDS_BYTES, stream);
    if (e != hipSuccess) fprintf(stderr, "kernel_launch: cooperative launch failed: %s (grid %d)\n", hipGetErrorString(e), grid);
}
```

```cpp
#include <hip/hip_runtime.h>
#include <hip/hip_cooperative_groups.h>
#include <cstdio>
#include <cstdint>
namespace cg = cooperative_groups;
namespace pg8 {
#define PG8_LAS __attribute__((address_space(3)))
typedef unsigned short bf16_t;
typedef short bf16x8 __attribute__((ext_vector_type(8)));
typedef float f32x4 __attribute__((ext_vector_type(4)));
typedef unsigned u32x4 __attribute__((ext_vector_type(4)));
constexpr int BM = 256, BK = 64, HALF = 128, HTB = HALF * BK * 2  , STAGE_BYTES = 8 * HTB, NXCD = 8, WGM = 8;

__host__ __device__ __forceinline__ int lds_byte(int r, int c) { const int st = (r >> 4) * 2 + (c >> 5), rr = r & 15, cc = c & 31, ob = rr * 64 + cc * 2; return st * 1024 + (ob ^ (((ob >> 9) & 1) << 5)); }
__host__ __device__ __forceinline__ void stage_rc(int b, int& R, int& C) { const int st = b / 1024, sb = b % 1024, swz = sb ^ (((sb >> 9) & 1) << 5); R = (st >> 1) * 16 + swz / 64; C = (st & 1) * 32 + (swz % 64) / 2; }
__host__ __device__ __forceinline__ int perm32(int rho) { const int n = rho >> 4, i = rho & 15; return 8 * (i >> 2) + 4 * n + (i & 3); }

struct Unit { int pm, pn; };
struct Gemm { const bf16_t* A; const bf16_t* Bt; int M, N, K; size_t a_tstep; };

struct StaticOrder {
    int nM, nN, nwg, G, c;
    __host__ __device__ void init(int M, int N, int G_, int c_) { nM = M / BM; nN = N / BM; nwg = nM * nN; G = G_; c = c_; }
    __host__ __device__ bool next(int i, Unit& u) const {
        const long L = (long)i * G + c; if (L >= nwg) return false;
        int wgid = (int)L; { const int q = nwg / NXCD, r = nwg % NXCD, xcd = wgid % NXCD, off = wgid / NXCD; wgid = (xcd < r ? xcd * (q + 1) : r * (q + 1) + (xcd - r) * q) + off; }
        const int nig = WGM * nN, gid = wgid / nig, fm = gid * WGM, gsz = (nM - fm) < WGM ? (nM - fm) : WGM;
        u.pm = fm + ((wgid % nig) % gsz); u.pn = (wgid % nig) / gsz; return true;
    }
    __device__ __forceinline__ void a_ready(const Unit&) const {}
    __device__ __forceinline__ void done(const Unit&) const {}
};
__device__ __forceinline__ unsigned cvt_pk_bf16(float lo, float hi) { unsigned r; asm volatile("v_cvt_pk_bf16_f32 %0, %1, %2" : "=v"(r) : "v"(lo), "v"(hi)); return r; }
typedef float f32x2 __attribute__((ext_vector_type(2)));
template <class Epi, class Sched, bool ALIGN_EPI = false, bool SP2 = false>
__device__ __forceinline__ void gemm_phase(PG8_LAS unsigned char* lds, const Gemm g, const Sched& S, const Epi& E, const int wid  ) {
    int lane; asm volatile("v_mbcnt_lo_u32_b32 %0, -1, 0\n\tv_mbcnt_hi_u32_b32 %0, -1, %0\n\ts_nop 1" : "=v"(lane));
    const int tid = wid * 64 + lane, wr = wid >> 2, wc = wid & 3, fr = lane & 15, fq = lane >> 4;
    const int K = g.K, nt = K / BK;
    unsigned voffA[2], voffB[2];
#pragma unroll
    for (int i = 0; i < 2; ++i) { int R, C; stage_rc(tid * 16 + i * 8192, R, C); const int Rb = Epi::PERM ? ((R & ~31) + perm32(R & 31)) : R;
        voffA[i] = (unsigned)(R * K + C) * 2u; voffB[i] = (unsigned)(Rb * K + C) * 2u; }
    const size_t kstep = (size_t)(BK * 2);
    const size_t hstep = (size_t)HALF * K * 2;
    const size_t tstep = 2 * hstep;
    const unsigned ldsw = (unsigned)wid * 1024u;
    const int aoff = lds_byte(wr * 64 + fr, fq * 8), boff = lds_byte(wc * 32 + fr, fq * 8);
#define PG8_SA(b, h) (((b) * 2 + (h)) * HTB)
#define PG8_SB(b, h) ((4 + (b) * 2 + (h)) * HTB)
#define PG8_STAGE(bufoff, gbase, voff) do { _Pragma("unroll") for (int _i = 0; _i < 2; ++_i) \
        __builtin_amdgcn_global_load_lds((const unsigned*)((const char*)(gbase) + (voff)[_i]), (PG8_LAS unsigned*)(lds + (bufoff) + ldsw + _i * 8192), 16, 0, 0); } while (0)
#define PG8_LDA(dst, b, h) do { _Pragma("unroll") for (int m = 0; m < 4; ++m) _Pragma("unroll") for (int k = 0; k < 2; ++k) dst[m][k] = *(const PG8_LAS bf16x8*)(lds + PG8_SA(b, h) + aoff + m * 2048 + k * 1024); } while (0)
#define PG8_LDB(dst, b, h) do { _Pragma("unroll") for (int n = 0; n < 2; ++n) _Pragma("unroll") for (int k = 0; k < 2; ++k) dst[n][k] = *(const PG8_LAS bf16x8*)(lds + PG8_SB(b, h) + boff + n * 2048 + k * 1024); } while (0)
#define PG8_MMA(ai, bj, At, Bt) do { __builtin_amdgcn_s_setprio(1); _Pragma("unroll") for (int m = 0; m < 4; ++m) _Pragma("unroll") for (int n = 0; n < 2; ++n) _Pragma("unroll") for (int k = 0; k < 2; ++k) \
        acc[ai][bj][m][n] = __builtin_amdgcn_mfma_f32_16x16x32_bf16(Bt[n][k], At[m][k], acc[ai][bj][m][n], 0, 0, 0); __builtin_amdgcn_s_setprio(0); } while (0)
#define PG8_WAIT_V(n) asm volatile("s_waitcnt vmcnt(" #n ")" ::: "memory")
#define PG8_WAIT_L(n) asm volatile("s_waitcnt lgkmcnt(" #n ")" ::: "memory")
#define PG8_BAR __builtin_amdgcn_s_barrier()
#define PG8_SCHED __builtin_amdgcn_sched_barrier(0)
    Unit cur, nxt; int ui = 0;
    if (!S.next(0, cur)) return;
    f32x4 acc[2][2][4][2];
#pragma unroll
    for (int a = 0; a < 2; ++a)
#pragma unroll
        for (int b = 0; b < 2; ++b)
#pragma unroll
            for (int m = 0; m < 4; ++m)
#pragma unroll
                for (int n = 0; n < 2; ++n) acc[a][b][m][n] = (f32x4){0.f, 0.f, 0.f, 0.f};
    bf16x8 At[4][2], B0[2][2], B1[2][2];
    const char* cA = (const char*)g.A + (size_t)cur.pm * g.a_tstep; const char* cB = (const char*)g.Bt + (size_t)cur.pn * tstep;
    S.a_ready(cur);
    if constexpr (SP2) {
        PG8_STAGE(PG8_SB(0, 0), cB, voffB); PG8_STAGE(PG8_SB(0, 1), cB + hstep, voffB); PG8_STAGE(PG8_SA(0, 0), cA, voffA); PG8_STAGE(PG8_SA(0, 1), cA + hstep, voffA);
        if (wr == 1) PG8_BAR;
        PG8_WAIT_V(2); PG8_BAR;
        PG8_STAGE(PG8_SB(1, 0), cB + kstep, voffB); PG8_STAGE(PG8_SA(1, 0), cA + kstep, voffA); PG8_STAGE(PG8_SB(1, 1), cB + hstep + kstep, voffB);
        PG8_WAIT_V(6); PG8_BAR;
    } else {
        PG8_STAGE(PG8_SB(0, 0), cB, voffB); PG8_STAGE(PG8_SA(0, 0), cA, voffA); PG8_STAGE(PG8_SB(0, 1), cB + hstep, voffB); PG8_STAGE(PG8_SA(0, 1), cA + hstep, voffA);
        if (wr == 1) PG8_BAR;
        PG8_WAIT_V(4); PG8_BAR;
        PG8_STAGE(PG8_SB(1, 0), cB + kstep, voffB); PG8_STAGE(PG8_SA(1, 0), cA + kstep, voffA); PG8_STAGE(PG8_SB(1, 1), cB + hstep + kstep, voffB);
        PG8_WAIT_V(6); PG8_BAR;
    }
    for (;;) {
        const bool has_next = S.next(ui + 1, nxt);
        const char* nA = has_next ? (const char*)g.A + (size_t)nxt.pm * g.a_tstep : cA; const char* nB = has_next ? (const char*)g.Bt + (size_t)nxt.pn * tstep : cB;
        for (int t = 0; t < nt; t += 2) {
            const bool last = (t == nt - 2);
            const char* a1 = cA + (size_t)(t + 1) * kstep;
            const char* a2 = last ? nA : cA + (size_t)(t + 2) * kstep; const char* b2 = last ? nB : cB + (size_t)(t + 2) * kstep;
            const char* a3 = a2 + kstep; const char* b3 = b2 + kstep;
            if (last && has_next) S.a_ready(nxt);
            if constexpr (SP2) {
            PG8_LDB(B0, 0, 0); PG8_LDB(B1, 0, 1); PG8_SCHED; PG8_LDA(At, 0, 0); PG8_STAGE(PG8_SA(1, 1), a1 + hstep, voffA);
            PG8_WAIT_V(8); PG8_WAIT_L(0); PG8_BAR; PG8_MMA(0, 0, At, B0); PG8_MMA(0, 1, At, B1); PG8_BAR; PG8_SCHED;
            PG8_LDA(At, 0, 1); PG8_STAGE(PG8_SB(0, 0), b2, voffB); PG8_STAGE(PG8_SB(0, 1), b2 + hstep, voffB); PG8_STAGE(PG8_SA(0, 0), a2, voffA);
            PG8_WAIT_V(8); PG8_WAIT_L(0); PG8_BAR; PG8_MMA(1, 0, At, B0); PG8_MMA(1, 1, At, B1); PG8_BAR; PG8_SCHED;
            PG8_LDB(B0, 1, 0); PG8_LDB(B1, 1, 1); PG8_SCHED; PG8_LDA(At, 1, 0); PG8_STAGE(PG8_SA(0, 1), a2 + hstep, voffA);
            PG8_WAIT_V(8); PG8_WAIT_L(0); PG8_BAR; PG8_MMA(0, 0, At, B0); PG8_MMA(0, 1, At, B1); PG8_BAR; PG8_SCHED;
            PG8_LDA(At, 1, 1); PG8_STAGE(PG8_SB(1, 0), b3, voffB); PG8_STAGE(PG8_SB(1, 1), b3 + hstep, voffB); PG8_STAGE(PG8_SA(1, 0), a3, voffA);
            PG8_WAIT_V(8); PG8_WAIT_L(0); PG8_BAR; PG8_MMA(1, 0, At, B0); PG8_MMA(1, 1, At, B1); PG8_BAR; PG8_SCHED;
            } else {
            PG8_LDB(B0, 0, 0); PG8_SCHED; PG8_LDA(At, 0, 0); PG8_STAGE(PG8_SA(1, 1), a1 + hstep, voffA);
            PG8_WAIT_L(8); PG8_BAR; PG8_WAIT_L(0); PG8_MMA(0, 0, At, B0); PG8_BAR; PG8_SCHED;
            PG8_LDB(B1, 0, 1); PG8_STAGE(PG8_SB(0, 0), b2, voffB);
            PG8_BAR; PG8_WAIT_L(0); PG8_MMA(0, 1, At, B1); PG8_BAR;
            PG8_LDA(At, 0, 1); PG8_STAGE(PG8_SA(0, 0), a2, voffA);
            PG8_BAR; PG8_WAIT_L(0); PG8_MMA(1, 0, At, B0); PG8_BAR; PG8_SCHED;
            PG8_STAGE(PG8_SB(0, 1), b2 + hstep, voffB);
            PG8_WAIT_V(6); PG8_BAR; PG8_MMA(1, 1, At, B1); PG8_BAR;
            PG8_LDB(B0, 1, 0); PG8_SCHED; PG8_LDA(At, 1, 0); PG8_STAGE(PG8_SA(0, 1), a2 + hstep, voffA);
            PG8_WAIT_L(8); PG8_BAR; PG8_WAIT_L(0); PG8_MMA(0, 0, At, B0); PG8_BAR; PG8_SCHED;
            PG8_LDB(B1, 1, 1); PG8_STAGE(PG8_SB(1, 0), b3, voffB);
            PG8_BAR; PG8_WAIT_L(0); PG8_MMA(0, 1, At, B1); PG8_BAR;
            PG8_LDA(At, 1, 1); PG8_STAGE(PG8_SA(1, 0), a3, voffA);
            PG8_BAR; PG8_WAIT_L(0); PG8_MMA(1, 0, At, B0); PG8_BAR; PG8_SCHED;
            PG8_STAGE(PG8_SB(1, 1), b3 + hstep, voffB);
            PG8_WAIT_V(6); PG8_BAR; PG8_MMA(1, 1, At, B1); PG8_BAR;
            }
        }
        if constexpr (ALIGN_EPI) { if (wr == 0) PG8_BAR; }
        if constexpr (!Epi::AFTER_DRAIN) { E(acc, cur, wr, wc, fr, fq); S.done(cur); }
        if (!has_next) break;
#pragma unroll
        for (int a = 0; a < 2; ++a)
#pragma unroll
            for (int b = 0; b < 2; ++b)
#pragma unroll
                for (int m = 0; m < 4; ++m)
#pragma unroll
                    for (int n = 0; n < 2; ++n) acc[a][b][m][n] = (f32x4){0.f, 0.f, 0.f, 0.f};
        cur = nxt; cA = nA; cB = nB; ++ui;
        if constexpr (ALIGN_EPI) { if (wr == 1) PG8_BAR; }
    }
    PG8_WAIT_V(0);
    if constexpr (!ALIGN_EPI) { if (wr == 0) PG8_BAR; }
    PG8_BAR;
    if constexpr (Epi::AFTER_DRAIN) { E.fused(acc, cur, wr, wc, fr, fq, lds, wid, lane); S.done(cur); }
#undef PG8_SA
#undef PG8_SB
#undef PG8_STAGE
#undef PG8_LDA
#undef PG8_LDB
#undef PG8_MMA
#undef PG8_WAIT_V
#undef PG8_WAIT_L
#undef PG8_BAR
#undef PG8_SCHED
}
}

#define LAS __attribute__((address_space(3)))
using pg8::bf16_t; using pg8::bf16x8; using pg8::f32x4; using pg8::u32x4; using pg8::cvt_pk_bf16;
typedef unsigned u32x2 __attribute__((ext_vector_type(2)));
typedef float f32x16 __attribute__((ext_vector_type(16)));

constexpr int S_ = 16384, D_ = 2048, DIN = 5200, ZLD = 5376, DFF = 5632;
constexpr int OFF_Q = 1024, OFF_K = 2048, OFF_V = 3072, OFF_QI = 4096, OFF_KI = 5120, OFF_WI = 5184;
constexpr float EPS_ = 1e-6f;
constexpr int UP_ROWS = 254;
constexpr int UP_TILES = 65;
constexpr size_t WS_WIN = 0;
constexpr size_t WS_WOUT = WS_WIN + (size_t)ZLD * D_ * 2;
constexpr size_t WS_WUP = WS_WOUT + (size_t)D_ * D_ * 2;
constexpr size_t WS_WDN = WS_WUP + (size_t)2 * DFF * D_ * 2;
constexpr size_t WS_PW = WS_WDN + (size_t)D_ * DFF * 2;
constexpr size_t WS_H = WS_PW + (size_t)4 * 256 * 256 * 2;
constexpr size_t WS_Z = WS_H + (size_t)(S_ + 128) * D_ * 2;
constexpr size_t WS_YMIX = WS_Z + (size_t)S_ * ZLD * 2;
constexpr size_t WS_DP = WS_YMIX + (size_t)S_ * D_ * 2;
constexpr size_t WS_SEL = WS_DP + (size_t)S_ * 1024 * 2;
constexpr size_t WS_KV8 = WS_SEL + (size_t)S_ * 256 * 4;
constexpr size_t WS_KI = WS_KV8 + (size_t)S_ * 2048;
constexpr size_t WS_BAR = WS_KI + (size_t)S_ * 64 * 2;
constexpr size_t WS_END = WS_BAR + 16384;
constexpr size_t WS_ACT = WS_Z;
static_assert((size_t)S_ * DFF * 2 <= (size_t)S_ * ZLD * 2 + (size_t)S_ * D_ * 2, "act overlay");
constexpr int LDS_XL = pg8::STAGE_BYTES;
constexpr int LDS_BARST = pg8::STAGE_BYTES + 8192;
constexpr int LDS_BYTES = pg8::STAGE_BYTES + 8192 + 256;

struct Params { const float* in[13]; float* out; unsigned char* ws; };

__device__ __forceinline__ float bf_lo(unsigned v) { return __uint_as_float(v << 16); }
__device__ __forceinline__ float bf_hi(unsigned v) { return __uint_as_float(v & 0xffff0000u); }
__device__ __forceinline__ float wave_sum(float v) {
#pragma unroll
    for (int o = 1; o < 64; o <<= 1) v += __shfl_xor(v, o);
    return v;
}
__device__ __forceinline__ float wave_max(float v) {
#pragma unroll
    for (int o = 1; o < 64; o <<= 1) v = fmaxf(v, __shfl_xor(v, o));
    return v;
}
template <int CTRL> __device__ __forceinline__ float dpp_f(float v) { return __int_as_float(__builtin_amdgcn_update_dpp(0, __float_as_int(v), CTRL, 0xF, 0xF, true)); }
__device__ __forceinline__ float red16(float v) { v += dpp_f<0xB1>(v); v += dpp_f<0x4E>(v); v += dpp_f<0x141>(v); v += dpp_f<0x140>(v); return v; }
__device__ __forceinline__ f32x4 ror1(f32x4 v) { f32x4 r; r.x = dpp_f<0x121>(v.x); r.y = dpp_f<0x121>(v.y); r.z = dpp_f<0x121>(v.z); r.w = dpp_f<0x121>(v.w); return r; }
__device__ __forceinline__ f32x4 ror2(f32x4 v) { f32x4 r; r.x = dpp_f<0x122>(v.x); r.y = dpp_f<0x122>(v.y); r.z = dpp_f<0x122>(v.z); r.w = dpp_f<0x122>(v.w); return r; }
__device__ __forceinline__ f32x4 sel4(bool c, f32x4 a, f32x4 b) { f32x4 r; r.x = c ? a.x : b.x; r.y = c ? a.y : b.y; r.z = c ? a.z : b.z; r.w = c ? a.w : b.w; return r; }
__device__ __forceinline__ float dot8(u32x4 a, u32x4 b) { float acc = 0.f;
    asm volatile("v_dot2c_f32_bf16 %0, %1, %5\n\tv_dot2c_f32_bf16 %0, %2, %6\n\tv_dot2c_f32_bf16 %0, %3, %7\n\tv_dot2c_f32_bf16 %0, %4, %8\n\ts_nop 2"
                 : "+v"(acc) : "v"(a.x), "v"(a.y), "v"(a.z), "v"(a.w), "v"(b.x), "v"(b.y), "v"(b.z), "v"(b.w));
    return acc; }
__device__ __forceinline__ int mbcnt64(unsigned long long m) { return __builtin_amdgcn_mbcnt_hi((unsigned)(m >> 32), __builtin_amdgcn_mbcnt_lo((unsigned)m, 0)); }
#define LDS_WAIT() asm volatile("s_waitcnt lgkmcnt(0)" ::: "memory")
__device__ __forceinline__ int lane_id() { int l; asm volatile("v_mbcnt_lo_u32_b32 %0, -1, 0\n\tv_mbcnt_hi_u32_b32 %0, -1, %0\n\ts_nop 1" : "=v"(l)); return l; }

__device__ __forceinline__ void transpose_item(const float* __restrict__ W, int N, int src_n0, int n_valid, bf16_t* __restrict__ WT, int Kd, int dst_row0, int k0,
                                               const float* __restrict__ scale, LAS float* scr, int lane) {
    const int c4 = (lane & 15) * 4, kr = lane >> 4;
#pragma unroll 4
    for (int i = 0; i < 16; ++i) { const int kk = 4 * i + kr;
        f32x4 v = {0.f, 0.f, 0.f, 0.f};
        if (c4 < n_valid) v = *(const f32x4*)(W + (size_t)(k0 + kk) * N + src_n0 + c4);
        LAS float* d = scr + kk * 65 + c4; d[0] = v.x; d[1] = v.y; d[2] = v.z; d[3] = v.w; }
    LDS_WAIT();
    const int c8 = lane & 7;
#pragma unroll
    for (int j = 0; j < 8; ++j) { const int n = (lane >> 3) + 8 * j; const LAS float* s = scr + (8 * c8) * 65 + n;
        const float sc = (scale != nullptr && n < n_valid) ? scale[src_n0 + n] : 1.f;
        u32x4 o; o.x = cvt_pk_bf16(s[0 * 65] * sc, s[1 * 65] * sc); o.y = cvt_pk_bf16(s[2 * 65] * sc, s[3 * 65] * sc); o.z = cvt_pk_bf16(s[4 * 65] * sc, s[5 * 65] * sc); o.w = cvt_pk_bf16(s[6 * 65] * sc, s[7 * 65] * sc);
        *(u32x4*)(WT + (size_t)(dst_row0 + n) * Kd + k0 + 8 * c8) = o; }
    LDS_WAIT();
}
__device__ __forceinline__ void rmsnorm_row(const float* __restrict__ xrow, const float* __restrict__ g, bf16_t* __restrict__ orow, int lane) {
    const f32x4* xr = (const f32x4*)xrow + lane; f32x4 v[8]; float s = 0.f;
#pragma unroll
    for (int j = 0; j < 8; ++j) { v[j] = xr[64 * j]; s += (v[j].x * v[j].x + v[j].y * v[j].y) + (v[j].z * v[j].z + v[j].w * v[j].w); }
    const float r = 1.f / sqrtf(wave_sum(s) * (1.f / D_) + EPS_);
    const f32x4* gr = (const f32x4*)g + lane; u32x2* o8 = (u32x2*)orow + lane;
#pragma unroll
    for (int j = 0; j < 8; ++j) { const f32x4 gg = gr[64 * j]; u32x2 o; o.x = cvt_pk_bf16(v[j].x * r * gg.x, v[j].y * r * gg.y); o.y = cvt_pk_bf16(v[j].z * r * gg.z, v[j].w * r * gg.w); o8[64 * j] = o; }
}

struct EpiStoreBf16 {
    static constexpr bool PERM = true, AFTER_DRAIN = false;
    bf16_t* O; int ldc; bf16_t* KI;
    __device__ __forceinline__ void operator()(const f32x4 (&acc)[2][2][4][2], const pg8::Unit& u, int wr, int wc, int fr, int fq) const {
        const int row0 = u.pm * 256 + wr * 64 + fr, col0 = u.pn * 256 + wc * 32 + 8 * fq;
#pragma unroll
        for (int ai = 0; ai < 2; ++ai)
#pragma unroll
            for (int m = 0; m < 4; ++m) { bf16_t* rowp = O + (size_t)(row0 + ai * 128 + m * 16) * ldc + col0;
#pragma unroll
                for (int bj = 0; bj < 2; ++bj) { const f32x4 v0 = acc[ai][bj][m][0], v1 = acc[ai][bj][m][1];
                    u32x4 o; o.x = cvt_pk_bf16(v0.x, v0.y); o.y = cvt_pk_bf16(v0.z, v0.w); o.z = cvt_pk_bf16(v1.x, v1.y); o.w = cvt_pk_bf16(v1.z, v1.w);
                    *(u32x4*)(rowp + bj * 128) = o;
                    if (bj == 0 && u.pn == 20 && wc < 2) { const int row = row0 + ai * 128 + m * 16; ((u32x4*)KI)[(size_t)(row >> 5) * 256 + (4 * wc + fq) * 32 + (row & 31)] = o; } }
                asm volatile("" ::: "memory"); }
    }
};
struct EpiPool {
    static constexpr bool PERM = true, AFTER_DRAIN = false;
    bf16_t* O;
    __device__ __forceinline__ void operator()(const f32x4 (&acc)[2][2][4][2], const pg8::Unit& u, int wr, int wc, int fr, int fq) const {
        const int g = u.pm >> 6, row0 = (u.pm & 63) * 256 + wr * 64 + fr, col0 = g * 256 + wc * 32 + 8 * fq;
#pragma unroll
        for (int ai = 0; ai < 2; ++ai)
#pragma unroll
            for (int m = 0; m < 4; ++m) { bf16_t* rowp = O + (size_t)(row0 + ai * 128 + m * 16) * D_ + col0;
#pragma unroll
                for (int bj = 0; bj < 2; ++bj) { const f32x4 v0 = acc[ai][bj][m][0], v1 = acc[ai][bj][m][1];
                    u32x4 o; o.x = cvt_pk_bf16(v0.x, v0.y); o.y = cvt_pk_bf16(v0.z, v0.w); o.z = cvt_pk_bf16(v1.x, v1.y); o.w = cvt_pk_bf16(v1.z, v1.w);
                    *(u32x4*)(rowp + bj * 128) = o; } }
    }
};
struct PoolOrder {
    int G, c;
    __device__ __forceinline__ bool next(int i, pg8::Unit& u) const { const int L = i * G + c; if (L >= 256) return false; u.pm = L; u.pn = L >> 6; return true; }
    __device__ __forceinline__ void a_ready(const pg8::Unit&) const {}
    __device__ __forceinline__ void done(const pg8::Unit&) const {}
};
struct EpiResid {
    static constexpr bool PERM = false, AFTER_DRAIN = false;
    const float* src; float* dst;
    __device__ __forceinline__ void operator()(const f32x4 (&acc)[2][2][4][2], const pg8::Unit& u, int wr, int wc, int fr, int fq) const {
        const int row0 = u.pm * 256 + wr * 64 + fr, col0 = u.pn * 256 + wc * 32 + 4 * fq;
#pragma unroll
        for (int ai = 0; ai < 2; ++ai)
#pragma unroll
            for (int m = 0; m < 4; ++m) { const size_t off = (size_t)(row0 + ai * 128 + m * 16) * D_ + col0;
#pragma unroll
                for (int bj = 0; bj < 2; ++bj)
#pragma unroll
                    for (int n = 0; n < 2; ++n) { const f32x4 s = *(const f32x4*)(src + off + bj * 128 + n * 16); *(f32x4*)(dst + off + bj * 128 + n * 16) = s + acc[ai][bj][m][n]; }
                asm volatile("" ::: "memory"); }
    }
};
struct EpiUp {
    static constexpr bool PERM = true, AFTER_DRAIN = false;
    bf16_t* ACT; const float* cw; const float* cb; LAS f32x4* xl;
    __device__ __forceinline__ void operator()(const f32x4 (&acc)[2][2][4][2], const pg8::Unit& u, int wr, int wc, int fr, int fq) const {
        if (fr >= 14) {
#pragma unroll
            for (int ai = 0; ai < 2; ++ai)
#pragma unroll
                for (int bj = 0; bj < 2; ++bj)
#pragma unroll
                    for (int n = 0; n < 2; ++n) xl[((((wr * 4 + wc) * 2 + ai) * 2 + bj) * 2 + n) * 8 + fq * 2 + (fr - 14)] = acc[ai][bj][3][n];
        }
        LDS_WAIT();
        __builtin_amdgcn_s_barrier();
        asm volatile("" ::: "memory");
        const int t0 = UP_ROWS * u.pm - 2 + 64 * wr + fr, r0 = 64 * wr + fr;
        const int chb = 128 * u.pn + 32 * wc + 8 * fq;
        const int swr = wr ^ 1;
#pragma unroll
        for (int n = 0; n < 2; ++n) {
            const int ch = chb + 4 * n;
            f32x4 w0[2], w1[2], w2[2], bb[2];
#pragma unroll
            for (int bj = 0; bj < 2; ++bj) { const int c = ch + bj * DFF; w0[bj] = *(const f32x4*)(cw + c); w1[bj] = *(const f32x4*)(cw + 2 * DFF + c); w2[bj] = *(const f32x4*)(cw + 4 * DFF + c); bb[bj] = *(const f32x4*)(cb + c); }
#pragma unroll
            for (int ai = 0; ai < 2; ++ai) {
                const int sai = (wr == 1) ? ai : 0;
                f32x4 h14[2], h15[2], pr1[2], pr2[2];
#pragma unroll
                for (int bj = 0; bj < 2; ++bj) { const int base = ((((swr * 4 + wc) * 2 + sai) * 2 + bj) * 2 + n) * 8 + fq * 2; h14[bj] = xl[base]; h15[bj] = xl[base + 1]; pr1[bj] = h15[bj]; pr2[bj] = (fr == 0) ? h14[bj] : h15[bj]; }
#pragma unroll
                for (int m = 0; m < 4; ++m) {
                    f32x4 cc[2];
#pragma unroll
                    for (int bj = 0; bj < 2; ++bj) { const f32x4 X = acc[ai][bj][m][n], R1 = ror1(X), R2 = ror2(X);
                        const f32x4 p1 = sel4(fr >= 1, R1, pr1[bj]), p2 = sel4(fr >= 2, R2, pr2[bj]);
                        pr1[bj] = R1; pr2[bj] = R2;
                        cc[bj] = bb[bj] + w0[bj] * p2 + w1[bj] * p1 + w2[bj] * X; }
                    const f32x4 gt = cc[0], vl = cc[1]; f32x4 o;
                    o.x = gt.x * __builtin_amdgcn_rcpf(1.f + __expf(-gt.x)) * vl.x; o.y = gt.y * __builtin_amdgcn_rcpf(1.f + __expf(-gt.y)) * vl.y;
                    o.z = gt.z * __builtin_amdgcn_rcpf(1.f + __expf(-gt.z)) * vl.z; o.w = gt.w * __builtin_amdgcn_rcpf(1.f + __expf(-gt.w)) * vl.w;
                    const int t = t0 + 128 * ai + 16 * m, r = r0 + 128 * ai + 16 * m;
                    if (r >= 2 && t < S_) { u32x2 ov; ov.x = cvt_pk_bf16(o.x, o.y); ov.y = cvt_pk_bf16(o.z, o.w); *(u32x2*)(ACT + (size_t)t * DFF + ch) = ov; }
                }
            }
        }
    }
};

__device__ __forceinline__ unsigned f2ord(float f) { const unsigned u = __float_as_uint(f); return u ^ ((u >> 31) ? 0xFFFFFFFFu : 0x80000000u); }
__device__ __forceinline__ unsigned ord2bits(unsigned k) { return (k & 0x80000000u) ? (k ^ 0x80000000u) : ~k; }
__device__ __forceinline__ int topk_compact(LAS u32x2* buf, int cnt, float& tau) {
    const int lane = lane_id();
    LDS_WAIT();
    unsigned key[12], idx[12];
    unsigned kmin = 0xFFFFFFFFu, kmax = 0u;
#pragma unroll
    for (int j = 0; j < 12; ++j) { const int e = j * 64 + lane; const u32x2 v = buf[e]; const bool ok = e < cnt; const unsigned k = f2ord(__uint_as_float(v.x)); key[j] = ok ? k : 0u; idx[j] = v.y;
        kmin = (ok && k < kmin) ? k : kmin; kmax = (ok && k > kmax) ? k : kmax; }
#pragma unroll
    for (int o = 1; o < 64; o <<= 1) { const unsigned a = (unsigned)__shfl_xor((int)kmin, o), b = (unsigned)__shfl_xor((int)kmax, o); kmin = a < kmin ? a : kmin; kmax = b > kmax ? b : kmax; }
    const unsigned diff = (unsigned)__builtin_amdgcn_readfirstlane((int)(kmin ^ kmax));
    int bit = diff ? (31 - __builtin_clz(diff)) : -1;
    unsigned T = (bit >= 0) ? (unsigned)__builtin_amdgcn_readfirstlane((int)kmin) & ~((2u << bit) - 1u) : (unsigned)__builtin_amdgcn_readfirstlane((int)kmin);
    int cT = cnt;
#pragma unroll 1
    for (; bit >= 0 && cT != 256; --bit) {
        const unsigned cand = T | (1u << bit); int c = 0;
#pragma unroll
        for (int j = 0; j < 12; ++j) c += __builtin_popcountll(__builtin_amdgcn_ballot_w64(key[j] >= cand));
        if (c >= 256) { T = cand; cT = c; }
    }
    int base = 0;
    if (cT == 256) {
#pragma unroll
        for (int j = 0; j < 12; ++j) { const bool g = key[j] >= T; const unsigned long long mk = __builtin_amdgcn_ballot_w64(g); const int pos = base + mbcnt64(mk);
            if (g) { u32x2 o; o.x = ord2bits(key[j]); o.y = idx[j]; buf[pos] = o; } base += __builtin_popcountll(mk); }
    } else {
#pragma unroll
        for (int j = 0; j < 12; ++j) { const bool g = key[j] > T; const unsigned long long mk = __builtin_amdgcn_ballot_w64(g); const int pos = base + mbcnt64(mk);
            if (g) { u32x2 o; o.x = ord2bits(key[j]); o.y = idx[j]; buf[pos] = o; } base += __builtin_popcountll(mk); }
#pragma unroll
        for (int j = 0; j < 12; ++j) { const bool g = key[j] == T; const unsigned long long mk = __builtin_amdgcn_ballot_w64(g); const int pos = base + mbcnt64(mk);
            if (g && pos < 256) { u32x2 o; o.x = ord2bits(key[j]); o.y = idx[j]; buf[pos] = o; } base += __builtin_popcountll(mk); }
    }
    tau = __uint_as_float(ord2bits(cT == 256 ? T - 1u : T));
    LDS_WAIT();
    return base < 256 ? base : 256;
}
__device__ __forceinline__ void indexer_block16(const bf16_t* __restrict__ Z, const bf16_t* __restrict__ KI, int* __restrict__ SEL, int qb, LAS unsigned char* lds, int wave) {
    const int lane = lane_id(), tid = wave * 64 + lane, half = lane >> 5, r = lane & 31;
    LAS u32x2* wbuf = (LAS u32x2*)lds + wave * 1536;
    LAS unsigned char* tiles = lds + 98304;
    LAS int* flags = (LAS int*)(lds + 98304 + 32768);
    const int tA = qb * 16 + wave * 2, tmine = tA + half;
    bf16x8 Af[4];
    { const int aq = tA + ((r >> 2) & 1), ah = (r >> 3) * 4 + (r & 3);
      const bf16_t* ap = Z + (size_t)aq * ZLD + OFF_QI + ah * 64 + half * 8;
#pragma unroll
      for (int kk = 0; kk < 4; ++kk) Af[kk] = *(const bf16x8*)(ap + kk * 16); }
    float wq[16];
    { const u32x4* wp = (const u32x4*)(Z + (size_t)tmine * ZLD + OFF_WI); const u32x4 a = wp[0], b = wp[1];
      wq[0] = bf_lo(a.x); wq[1] = bf_hi(a.x); wq[2] = bf_lo(a.y); wq[3] = bf_hi(a.y); wq[4] = bf_lo(a.z); wq[5] = bf_hi(a.z); wq[6] = bf_lo(a.w); wq[7] = bf_hi(a.w);
      wq[8] = bf_lo(b.x); wq[9] = bf_hi(b.x); wq[10] = bf_lo(b.y); wq[11] = bf_hi(b.y); wq[12] = bf_lo(b.z); wq[13] = bf_hi(b.z); wq[14] = bf_lo(b.w); wq[15] = bf_hi(b.w);
#pragma unroll
      for (int i = 0; i < 16; ++i) wq[i] *= 0.03125f; }
    const int ntiles = (qb * 16 + 16 + 127) >> 7;
    float tau = -__builtin_inff(); int cntA = 0, cntB = 0;
    const u32x4* gsrc = (const u32x4*)KI + tid;
    { const u32x4 g0 = gsrc[0], g1 = gsrc[512]; *(LAS u32x4*)(tiles + tid * 16) = g0; *(LAS u32x4*)(tiles + 8192 + tid * 16) = g1; }
    __syncthreads();
#pragma unroll 1
    for (int i = 0; i < ntiles; ++i) {
        u32x4 g0 = {0u, 0u, 0u, 0u}, g1 = {0u, 0u, 0u, 0u};
        const bool more = (i + 1 < ntiles);
        if (more) { g0 = gsrc[(size_t)(i + 1) * 1024]; g1 = gsrc[(size_t)(i + 1) * 1024 + 512]; }
        const LAS unsigned char* tb = tiles + (i & 1) * 16384 + lane * 16;
        float sc[4];
#pragma unroll
        for (int st = 0; st < 4; ++st) {
            bf16x8 Bc[4];
#pragma unroll
            for (int kk = 0; kk < 4; ++kk) Bc[kk] = *(const LAS bf16x8*)(tb + (st * 4 + kk) * 1024);
            f32x16 acc = {0.f, 0.f, 0.f, 0.f, 0.f, 0.f, 0.f, 0.f, 0.f, 0.f, 0.f, 0.f, 0.f, 0.f, 0.f, 0.f};
#pragma unroll
            for (int kk = 0; kk < 4; ++kk) acc = __builtin_amdgcn_mfma_f32_32x32x16_bf16(Af[kk], Bc[kk], acc, 0, 0, 0);
            float s0 = 0.f, s1 = 0.f;
#pragma unroll
            for (int h = 0; h < 16; h += 2) { const int b0 = __float_as_int(acc[h]), b1 = __float_as_int(acc[h + 1]);
                s0 = fmaf(wq[h], __int_as_float(b0 > 0 ? b0 : 0), s0); s1 = fmaf(wq[h + 1], __int_as_float(b1 > 0 ? b1 : 0), s1); }
            sc[st] = s0 + s1;
#ifdef DUP_SCORE
            { f32x16 acc2 = {0.f, 0.f, 0.f, 0.f, 0.f, 0.f, 0.f, 0.f, 0.f, 0.f, 0.f, 0.f, 0.f, 0.f, 0.f, 0.f};
#pragma unroll
              for (int kk = 0; kk < 4; ++kk) acc2 = __builtin_amdgcn_mfma_f32_32x32x16_bf16(Af[kk], Bc[3 - kk], acc2, 0, 0, 0);
              float t0 = 0.f, t1 = 0.f;
#pragma unroll
              for (int h = 0; h < 16; h += 2) { const int b0 = __float_as_int(acc2[h]), b1 = __float_as_int(acc2[h + 1]);
                  t0 = fmaf(wq[h], __int_as_float(b0 > 0 ? b0 : 0), t0); t1 = fmaf(wq[h + 1], __int_as_float(b1 > 0 ? b1 : 0), t1); }
              asm volatile("" :: "v"(t0 + t1)); }
#endif
        }
#pragma unroll
        for (int st = 0; st < 4; ++st) {
            const int key = i * 128 + st * 32 + r;
            const bool pass = (key <= tmine) && (sc[st] > tau);
            const unsigned long long mk = __builtin_amdgcn_ballot_w64(pass);
            if (mk != 0ull) {
                const unsigned lo = (unsigned)mk, hi = (unsigned)(mk >> 32);
                const int pre = half ? __builtin_amdgcn_mbcnt_hi(hi, 0) : __builtin_amdgcn_mbcnt_lo(lo, 0);
                const int base = half ? cntB : cntA;
                if (pass) { u32x2 o; o.x = __float_as_uint(sc[st]); o.y = (unsigned)key; wbuf[half * 768 + base + pre] = o; }
                cntA += __builtin_popcount(lo); cntB += __builtin_popcount(hi);
            }
        }
        if (more) { LAS unsigned char* nb = tiles + ((i + 1) & 1) * 16384; *(LAS u32x4*)(nb + tid * 16) = g0; *(LAS u32x4*)(nb + 8192 + tid * 16) = g1; }
        if (lane == 0) flags[(i & 1) * 8 + wave] = (cntA > 640 || cntB > 640) ? 1 : 0;
        __syncthreads();
        const int vote = flags[(i & 1) * 8 + (lane & 7)];
        if (__builtin_amdgcn_ballot_w64(vote != 0) != 0ull) {
            if (cntA > 256) { float nt; cntA = topk_compact(wbuf, cntA, nt); tau = half ? tau : nt; }
            if (cntB > 256) { float nt; cntB = topk_compact(wbuf + 768, cntB, nt); tau = half ? nt : tau; }
#ifdef DUP_COMPACT
            if (cntA >= 256) { float nt; cntA = topk_compact(wbuf, cntA, nt); tau = half ? tau : nt; }
            if (cntB >= 256) { float nt; cntB = topk_compact(wbuf + 768, cntB, nt); tau = half ? nt : tau; }
#endif
        }
    }
    if (cntA > 256) { float nt; cntA = topk_compact(wbuf, cntA, nt); }
    if (cntB > 256) { float nt; cntB = topk_compact(wbuf + 768, cntB, nt); }
    LDS_WAIT();
#pragma unroll
    for (int jj = 0; jj < 4; ++jj) { const int e = lane + 64 * jj;
        if (e < cntA) SEL[(size_t)tA * 256 + e] = (int)wbuf[e].y;
        if (e < cntB) SEL[(size_t)(tA + 1) * 256 + e] = (int)wbuf[768 + e].y; }
    __syncthreads();
}

__device__ __forceinline__ void attn_query(const bf16_t* __restrict__ Z, const int* __restrict__ SEL, bf16_t* __restrict__ YMIX, int t, LAS float* sbuf  ) {
    const int lane = lane_id(), hq = lane >> 4;
    const int nsel = (t + 1 < 256) ? (t + 1) : 256;
    int iv[4];
#pragma unroll
    for (int jj = 0; jj < 4; ++jj) { const int e = lane + 64 * jj; iv[jj] = (e < nsel) ? SEL[(size_t)t * 256 + e] : 0; }
    const bf16_t* qp = Z + (size_t)t * ZLD + OFF_Q + lane * 8;
    const u32x4 qa = *(const u32x4*)qp, qb = *(const u32x4*)(qp + 512);
#pragma unroll
    for (int jj = 0; jj < 4; ++jj) {
        if (jj * 64 < nsel) {
#pragma unroll 1
            for (int l0 = 0; l0 < 64; l0 += 8) {
                const int j0 = jj * 64 + l0; if (j0 >= nsel) break;
                u32x4 ka[8], kb[8];
#pragma unroll
                for (int u = 0; u < 8; ++u) { const int si = __builtin_amdgcn_readlane(iv[jj], l0 + u); const bf16_t* kp = Z + (size_t)si * ZLD + OFF_K + lane * 8; ka[u] = *(const u32x4*)kp; kb[u] = *(const u32x4*)(kp + 512); }
#pragma unroll
                for (int u = 0; u < 8; ++u) { float da = dot8(qa, ka[u]), db = dot8(qb, kb[u]);
                    da = red16(da); db = red16(db);
                    if ((lane & 15) == 0) { sbuf[hq * 256 + j0 + u] = da; sbuf[(4 + hq) * 256 + j0 + u] = db; } }
            }
        }
    }
    LDS_WAIT();
#pragma unroll 1
    for (int h = 0; h < 8; ++h) {
        float sv[4]; float mx = -__builtin_inff();
#pragma unroll
        for (int jj = 0; jj < 4; ++jj) { const int j = lane + 64 * jj; const float s = sbuf[h * 256 + j]; sv[jj] = (j < nsel) ? s : -__builtin_inff(); mx = fmaxf(mx, sv[jj]); }
        mx = wave_max(mx); float sm = 0.f;
#pragma unroll
        for (int jj = 0; jj < 4; ++jj) { const int j = lane + 64 * jj; sv[jj] = (j < nsel) ? __expf(sv[jj] - mx) : 0.f; sm += sv[jj]; }
        sm = wave_sum(sm); const float inv = 1.f / sm;
#pragma unroll
        for (int jj = 0; jj < 4; ++jj) sbuf[h * 256 + lane + 64 * jj] = sv[jj] * inv;
    }
    LDS_WAIT();
    float oa[8], ob[8];
#pragma unroll
    for (int i = 0; i < 8; ++i) { oa[i] = 0.f; ob[i] = 0.f; }
#pragma unroll
    for (int jj = 0; jj < 4; ++jj) {
        if (jj * 64 < nsel) {
#pragma unroll 1
            for (int l0 = 0; l0 < 64; l0 += 8) {
                const int j0 = jj * 64 + l0; if (j0 >= nsel) break;
                u32x4 va[8], vb[8];
#pragma unroll
                for (int u = 0; u < 8; ++u) { const int si = __builtin_amdgcn_readlane(iv[jj], l0 + u); const bf16_t* vp = Z + (size_t)si * ZLD + OFF_V + lane * 8; va[u] = *(const u32x4*)vp; vb[u] = *(const u32x4*)(vp + 512); }
                const LAS f32x4* pa4 = (const LAS f32x4*)(sbuf + hq * 256 + j0); const LAS f32x4* pb4 = (const LAS f32x4*)(sbuf + (4 + hq) * 256 + j0);
                const f32x4 pa0 = pa4[0], pa1 = pa4[1], pb0 = pb4[0], pb1 = pb4[1];
                const float pa[8] = {pa0.x, pa0.y, pa0.z, pa0.w, pa1.x, pa1.y, pa1.z, pa1.w}, pb[8] = {pb0.x, pb0.y, pb0.z, pb0.w, pb1.x, pb1.y, pb1.z, pb1.w};
#pragma unroll
                for (int u = 0; u < 8; ++u) {
                    oa[0] = fmaf(pa[u], bf_lo(va[u].x), oa[0]); oa[1] = fmaf(pa[u], bf_hi(va[u].x), oa[1]); oa[2] = fmaf(pa[u], bf_lo(va[u].y), oa[2]); oa[3] = fmaf(pa[u], bf_hi(va[u].y), oa[3]);
                    oa[4] = fmaf(pa[u], bf_lo(va[u].z), oa[4]); oa[5] = fmaf(pa[u], bf_hi(va[u].z), oa[5]); oa[6] = fmaf(pa[u], bf_lo(va[u].w), oa[6]); oa[7] = fmaf(pa[u], bf_hi(va[u].w), oa[7]);
                    ob[0] = fmaf(pb[u], bf_lo(vb[u].x), ob[0]); ob[1] = fmaf(pb[u], bf_hi(vb[u].x), ob[1]); ob[2] = fmaf(pb[u], bf_lo(vb[u].y), ob[2]); ob[3] = fmaf(pb[u], bf_hi(vb[u].y), ob[3]);
                    ob[4] = fmaf(pb[u], bf_lo(vb[u].z), ob[4]); ob[5] = fmaf(pb[u], bf_hi(vb[u].z), ob[5]); ob[6] = fmaf(pb[u], bf_lo(vb[u].w), ob[6]); ob[7] = fmaf(pb[u], bf_hi(vb[u].w), ob[7]);
                }
            }
        }
    }
    u32x4 o0, o1;
    o0.x = cvt_pk_bf16(oa[0], oa[1]); o0.y = cvt_pk_bf16(oa[2], oa[3]); o0.z = cvt_pk_bf16(oa[4], oa[5]); o0.w = cvt_pk_bf16(oa[6], oa[7]);
    o1.x = cvt_pk_bf16(ob[0], ob[1]); o1.y = cvt_pk_bf16(ob[2], ob[3]); o1.z = cvt_pk_bf16(ob[4], ob[5]); o1.w = cvt_pk_bf16(ob[6], ob[7]);
    bf16_t* yp = YMIX + (size_t)t * D_ + 1024 + lane * 8;
    *(u32x4*)yp = o0; *(u32x4*)(yp + 512) = o1;
    LDS_WAIT();
}


typedef float f32x2v __attribute__((ext_vector_type(2)));
__device__ __forceinline__ float red8(float v) { v += dpp_f<0xB1>(v); v += dpp_f<0x4E>(v); v += dpp_f<0x141>(v); return v; }
#ifndef KV8_AUX
#define KV8_AUX 1
#endif
__device__ __forceinline__ void kv8_issue(u32x4 (&buf)[8], __amdgpu_buffer_rsrc_t rs, int voff  , int sbase  , const int (&iv)[4], int b) {
    const int jj = b >> 3, l0 = (b & 7) * 8;
    const int ivb = (jj == 0) ? iv[0] : (jj == 1) ? iv[1] : (jj == 2) ? iv[2] : iv[3];
#pragma unroll
    for (int u = 0; u < 8; ++u) { const int si = __builtin_amdgcn_readlane(ivb, l0 + u); buf[u] = __builtin_amdgcn_raw_buffer_load_b128(rs, voff, si * 2048 + sbase, KV8_AUX); }
}
__device__ __forceinline__ void kv8_qk(const u32x4 (&buf)[8], const f32x2v (&q2)[8], LAS float* srow, int b, int lane) {
#pragma unroll
    for (int u = 0; u < 8; ++u) {
        const u32x4 k = buf[u];
        f32x2v s0 = q2[0] * __builtin_amdgcn_cvt_pk_f32_fp8(k.x, false), s1 = q2[1] * __builtin_amdgcn_cvt_pk_f32_fp8(k.x, true);
        s0 = __builtin_elementwise_fma(q2[2], __builtin_amdgcn_cvt_pk_f32_fp8(k.y, false), s0); s1 = __builtin_elementwise_fma(q2[3], __builtin_amdgcn_cvt_pk_f32_fp8(k.y, true), s1);
        s0 = __builtin_elementwise_fma(q2[4], __builtin_amdgcn_cvt_pk_f32_fp8(k.z, false), s0); s1 = __builtin_elementwise_fma(q2[5], __builtin_amdgcn_cvt_pk_f32_fp8(k.z, true), s1);
        s0 = __builtin_elementwise_fma(q2[6], __builtin_amdgcn_cvt_pk_f32_fp8(k.w, false), s0); s1 = __builtin_elementwise_fma(q2[7], __builtin_amdgcn_cvt_pk_f32_fp8(k.w, true), s1);
        const f32x2v t = s0 + s1;
        const float s = red8(t.x + t.y);
        if ((lane & 7) == 0) srow[b * 8 + u] = s;
    }
}
__device__ __forceinline__ void kv8_pv(const u32x4 (&buf)[8], f32x2v (&o2)[8], const LAS float* srow, int b) {
    const LAS f32x4* p4 = (const LAS f32x4*)(srow + b * 8);
    const f32x4 p0 = p4[0], p1 = p4[1];
    const float p[8] = {p0.x, p0.y, p0.z, p0.w, p1.x, p1.y, p1.z, p1.w};
#pragma unroll
    for (int u = 0; u < 8; ++u) {
        const u32x4 v = buf[u]; const f32x2v pp = {p[u], p[u]};
        o2[0] = __builtin_elementwise_fma(pp, __builtin_amdgcn_cvt_pk_f32_fp8(v.x, false), o2[0]); o2[1] = __builtin_elementwise_fma(pp, __builtin_amdgcn_cvt_pk_f32_fp8(v.x, true), o2[1]);
        o2[2] = __builtin_elementwise_fma(pp, __builtin_amdgcn_cvt_pk_f32_fp8(v.y, false), o2[2]); o2[3] = __builtin_elementwise_fma(pp, __builtin_amdgcn_cvt_pk_f32_fp8(v.y, true), o2[3]);
        o2[4] = __builtin_elementwise_fma(pp, __builtin_amdgcn_cvt_pk_f32_fp8(v.z, false), o2[4]); o2[5] = __builtin_elementwise_fma(pp, __builtin_amdgcn_cvt_pk_f32_fp8(v.z, true), o2[5]);
        o2[6] = __builtin_elementwise_fma(pp, __builtin_amdgcn_cvt_pk_f32_fp8(v.w, false), o2[6]); o2[7] = __builtin_elementwise_fma(pp, __builtin_amdgcn_cvt_pk_f32_fp8(v.w, true), o2[7]);
    }
}
__device__ __forceinline__ void attn_query8(const unsigned char* __restrict__ KV8, const bf16_t* __restrict__ Z, const int* __restrict__ SEL, bf16_t* __restrict__ YMIX, int t, LAS float* sbuf  ) {
    const int lane = lane_id(), hd = lane >> 3;
    const int nsel = (t + 1 < 256) ? (t + 1) : 256, nb = (nsel + 7) >> 3;
    int iv[4];
#pragma unroll
    for (int jj = 0; jj < 4; ++jj) { const int e = lane + 64 * jj; iv[jj] = (e < nsel) ? SEL[(size_t)t * 256 + e] : 0; }
    f32x2v qf[8];
    { const u32x4* qp = (const u32x4*)(Z + (size_t)t * ZLD + OFF_Q + lane * 16); const u32x4 a = qp[0], b = qp[1];
      qf[0] = (f32x2v){bf_lo(a.x), bf_hi(a.x)}; qf[1] = (f32x2v){bf_lo(a.y), bf_hi(a.y)}; qf[2] = (f32x2v){bf_lo(a.z), bf_hi(a.z)}; qf[3] = (f32x2v){bf_lo(a.w), bf_hi(a.w)};
      qf[4] = (f32x2v){bf_lo(b.x), bf_hi(b.x)}; qf[5] = (f32x2v){bf_lo(b.y), bf_hi(b.y)}; qf[6] = (f32x2v){bf_lo(b.z), bf_hi(b.z)}; qf[7] = (f32x2v){bf_lo(b.w), bf_hi(b.w)}; }
    const __amdgpu_buffer_rsrc_t rs = __builtin_amdgcn_make_buffer_rsrc((void*)KV8, 0, 0x7fffffff, 0x00020000);
    const int lvo = lane * 16;
    LAS float* srow = sbuf + hd * 256;
    u32x4 A[8], B[8], C[8];
    const int lb = nb - 1;
#define CLAMPB(x) ((x) < lb ? (x) : lb)
    kv8_issue(A, rs, lvo, 0, iv, 0);
    kv8_issue(B, rs, lvo, 0, iv, CLAMPB(1));
#pragma unroll 1
    for (int b = 0; b < nb; b += 3) {
        kv8_issue(C, rs, lvo, 0, iv, CLAMPB(b + 2));
        kv8_qk(A, qf, srow, b, lane);
        kv8_issue(A, rs, lvo, 0, iv, CLAMPB(b + 3));
        if (b + 1 < nb) kv8_qk(B, qf, srow, b + 1, lane);
        kv8_issue(B, rs, lvo, 0, iv, CLAMPB(b + 4));
        if (b + 2 < nb) kv8_qk(C, qf, srow, b + 2, lane);
    }
    kv8_issue(A, rs, lvo, 1024, iv, 0);
    kv8_issue(B, rs, lvo, 1024, iv, CLAMPB(1));
    LDS_WAIT();
#pragma unroll 1
    for (int h = 0; h < 8; ++h) {
        float sv[4]; float mx = -__builtin_inff();
#pragma unroll
        for (int jj = 0; jj < 4; ++jj) { const int j = lane + 64 * jj; const float s = sbuf[h * 256 + j]; sv[jj] = (j < nsel) ? s : -__builtin_inff(); mx = fmaxf(mx, sv[jj]); }
        mx = wave_max(mx); float sm = 0.f;
#pragma unroll
        for (int jj = 0; jj < 4; ++jj) { const int j = lane + 64 * jj; sv[jj] = (j < nsel) ? __expf(sv[jj] - mx) : 0.f; sm += sv[jj]; }
        sm = wave_sum(sm); const float inv = 1.f / sm;
#pragma unroll
        for (int jj = 0; jj < 4; ++jj) sbuf[h * 256 + lane + 64 * jj] = sv[jj] * inv;
    }
    LDS_WAIT();
    f32x2v o[8];
#pragma unroll
    for (int i = 0; i < 8; ++i) o[i] = (f32x2v){0.f, 0.f};
#pragma unroll 1
    for (int b = 0; b < nb; b += 3) {
        kv8_issue(C, rs, lvo, 1024, iv, CLAMPB(b + 2));
        kv8_pv(A, o, srow, b);
        kv8_issue(A, rs, lvo, 1024, iv, CLAMPB(b + 3));
        if (b + 1 < nb) kv8_pv(B, o, srow, b + 1);
        kv8_issue(B, rs, lvo, 1024, iv, CLAMPB(b + 4));
        if (b + 2 < nb) kv8_pv(C, o, srow, b + 2);
    }
#undef CLAMPB
    u32x4 o0, o1;
    o0.x = cvt_pk_bf16(o[0].x, o[0].y); o0.y = cvt_pk_bf16(o[1].x, o[1].y); o0.z = cvt_pk_bf16(o[2].x, o[2].y); o0.w = cvt_pk_bf16(o[3].x, o[3].y);
    o1.x = cvt_pk_bf16(o[4].x, o[4].y); o1.y = cvt_pk_bf16(o[5].x, o[5].y); o1.z = cvt_pk_bf16(o[6].x, o[6].y); o1.w = cvt_pk_bf16(o[7].x, o[7].y);
    u32x4* yp = (u32x4*)(YMIX + (size_t)t * D_ + 1024 + lane * 16);
    yp[0] = o0; yp[1] = o1;
    LDS_WAIT();
}

#define XB_TMO      128
#define XB_XCNT(j)  (256  + 64 * (j))
#define XB_XSUB(j)  (1280 + 64 * (j))
#define XB_XGEN(j)  (2304 + 64 * (j))
#define XB_TOP      3328
#define XB_TOPGEN   3392
#define XB_SPIN_CAP (1u << 23)
__device__ __forceinline__ unsigned xb_ld(unsigned* p)              { return __hip_atomic_load(p, __ATOMIC_RELAXED, __HIP_MEMORY_SCOPE_AGENT); }
__device__ __forceinline__ unsigned xb_add(unsigned* p, unsigned v) { return __hip_atomic_fetch_add(p, v, __ATOMIC_RELAXED, __HIP_MEMORY_SCOPE_AGENT); }
__device__ __forceinline__ unsigned xb_xcc_id() { return (unsigned)__builtin_amdgcn_s_getreg((3 << 11) | 20) & 0xFu; }
#define XB_SPIN(cond, bar) do { unsigned _sp = 0; while (cond) { __builtin_amdgcn_s_sleep(1); \
    if ((++_sp & 255u) == 0u) { if (xb_ld(&(bar)[XB_TMO])) break; if (_sp > XB_SPIN_CAP) { atomicAdd(&(bar)[XB_TMO], 1u); break; } } } } while (0)
__device__ __forceinline__ void xcd_barrier_complete(unsigned* bar, unsigned x, unsigned& nloc, unsigned& nx) {
    const unsigned G = gridDim.x * gridDim.y * gridDim.z;
    unsigned sum, cnt, mine, sp = 0u;
    for (;;) {
        sum = 0u; cnt = 0u; mine = 0u;
#pragma unroll
        for (unsigned j = 0; j < 16; ++j) { const unsigned c = xb_ld(&bar[XB_XCNT(j)]); sum += c; cnt += (c > 0u) ? 1u : 0u; mine = (j == x) ? c : mine; }
        if (sum == G) break;
        __builtin_amdgcn_s_sleep(1);
        if ((++sp & 255u) == 0u) { if (xb_ld(&bar[XB_TMO])) break; if (sp > XB_SPIN_CAP) { atomicAdd(&bar[XB_TMO], 1u); break; } }
    }
    nloc = mine > 0u ? mine : 1u; nx = cnt > 0u ? cnt : 1u;
}
__device__ __forceinline__ void xcd_barrier(unsigned* bar, volatile LAS unsigned* st, bool leader) {
    asm volatile("s_waitcnt vmcnt(0)" ::: "memory");
    __syncthreads();
    if (leader) {
        __builtin_amdgcn_s_waitcnt(0);
        const unsigned x = xb_xcc_id();
        unsigned nloc = st[0], nx = st[1];
        if (nloc == 0u) { xcd_barrier_complete(bar, x, nloc, nx); st[0] = nloc; st[1] = nx; }
        const unsigned old = xb_add(&bar[XB_XSUB(x)], 1u);
        const unsigned gen = old / nloc;
        if (old + 1u == (gen + 1u) * nloc) {
            __builtin_amdgcn_fence(__ATOMIC_RELEASE, "agent");
            asm volatile("s_waitcnt vmcnt(0)" ::: "memory");
            const unsigned og = xb_add(&bar[XB_TOP], 1u);
            const unsigned tg = og / nx;
            if (og + 1u == (tg + 1u) * nx) xb_add(&bar[XB_TOPGEN], 1u);
            else XB_SPIN(xb_ld(&bar[XB_TOPGEN]) == tg, bar);
            __builtin_amdgcn_fence(__ATOMIC_ACQUIRE, "agent");
            xb_add(&bar[XB_XGEN(x)], 1u);
            asm volatile("s_waitcnt vmcnt(0)" ::: "memory");
        } else {
            XB_SPIN(xb_ld(&bar[XB_XGEN(x)]) == gen, bar);
            __builtin_amdgcn_fence(__ATOMIC_ACQUIRE, "agent");
            asm volatile("s_waitcnt vmcnt(0)" ::: "memory");
        }
    }
    __syncthreads();
}

__global__ void __launch_bounds__(512, 2) mega(Params p) {
    extern __shared__ __attribute__((aligned(16))) unsigned char smem[];
    cg::grid_group grid = cg::this_grid();
    LAS unsigned char* lds = (LAS unsigned char*)smem;
    const int wave = __builtin_amdgcn_readfirstlane((int)threadIdx.x >> 6);
    const int nblk = gridDim.x, bid = blockIdx.x, gw = bid * 8 + wave, ngw = nblk * 8;
#define PHASE_IDS() const int lane = lane_id(), tid = wave * 64 + lane; (void)tid; (void)lane
    const float* x = p.in[0]; const float* attn_g = p.in[1]; const float* w_in = p.in[2]; const float* pool_w = p.in[3]; const float* pool_scale = p.in[4];
    const float* qn_g = p.in[5]; const float* kn_g = p.in[6]; const float* w_out = p.in[7]; const float* ffn_g = p.in[8]; const float* w_up = p.in[9];
    const float* conv_w = p.in[10]; const float* conv_b = p.in[11]; const float* w_down = p.in[12];
    bf16_t* WinT = (bf16_t*)(p.ws + WS_WIN); bf16_t* WoutT = (bf16_t*)(p.ws + WS_WOUT); bf16_t* WupT = (bf16_t*)(p.ws + WS_WUP); bf16_t* WdT = (bf16_t*)(p.ws + WS_WDN);
    bf16_t* PwT = (bf16_t*)(p.ws + WS_PW); bf16_t* Hb = (bf16_t*)(p.ws + WS_H); bf16_t* H = Hb + 2 * D_; bf16_t* Z = (bf16_t*)(p.ws + WS_Z);
    bf16_t* YMIX = (bf16_t*)(p.ws + WS_YMIX); bf16_t* Dp = (bf16_t*)(p.ws + WS_DP); int* SEL = (int*)(p.ws + WS_SEL); bf16_t* ACT = (bf16_t*)(p.ws + WS_ACT); unsigned char* KV8 = p.ws + WS_KV8; bf16_t* KI = (bf16_t*)(p.ws + WS_KI);
    float* out = p.out;
    unsigned* gbar = (unsigned*)(p.ws + WS_BAR); volatile LAS unsigned* gst = (volatile LAS unsigned*)(lds + LDS_BARST);
    { const bool ld0 = (wave == 0) && (lane_id() == 0);
      if (ld0) { gst[0] = 0u; gst[1] = 0u; (void)xb_add(&gbar[XB_XCNT(xb_xcc_id())], 1u); } }
#define GRID_BAR() xcd_barrier(gbar, gst, (wave == 0) && (lane_id() == 0))

#ifdef DUP_P0
    for (int rep0 = 0; rep0 < 2; ++rep0)
#endif
    {
        PHASE_IDS();
        LAS float* scr = (LAS float*)lds + wave * (64 * 65);
        constexpr int NB_IN = ZLD / 64, NB_UP = 2 * DFF / 64;
        constexpr int I_IN = 32 * NB_IN, I_OUT = 32 * 32, I_UP = 32 * NB_UP, I_DN = (DFF / 64) * 32, I_PW = 4 * 4 * 4;
        constexpr int NITEMS = I_IN + I_OUT + I_UP + I_DN + I_PW;
        for (int it = gw; it < NITEMS; it += ngw) {
            int r = it;
            if (r < I_IN) { const int nb = r % NB_IN, kb = r / NB_IN, n0 = nb * 64; int nv = DIN - n0; nv = nv < 0 ? 0 : (nv > 64 ? 64 : nv);
                transpose_item(w_in, DIN, n0, nv, WinT, D_, n0, kb * 64, nullptr, scr, lane); continue; }
            r -= I_IN;
            if (r < I_OUT) { const int nb = r % 32, kb = r / 32; transpose_item(w_out, D_, nb * 64, 64, WoutT, D_, nb * 64, kb * 64, nullptr, scr, lane); continue; }
            r -= I_OUT;
            if (r < I_UP) { const int nb = r % NB_UP, kb = r / NB_UP, n0 = nb * 64, tile = n0 >> 8, j = n0 & 255;
                const int src = (j < 128) ? (128 * tile + j) : (DFF + 128 * tile + (j - 128));
                transpose_item(w_up, 2 * DFF, src, 64, WupT, D_, n0, kb * 64, nullptr, scr, lane); continue; }
            r -= I_UP;
            if (r < I_DN) { const int nb = r % 32, kb = r / 32; transpose_item(w_down, D_, nb * 64, 64, WdT, DFF, nb * 64, kb * 64, nullptr, scr, lane); continue; }
            r -= I_DN;
            { const int g = r >> 4, rr = r & 15, nb = rr & 3, kb = rr >> 2;
              transpose_item(pool_w + (size_t)g * 65536, 256, nb * 64, 64, PwT + (size_t)g * 65536, 256, nb * 64, kb * 64, pool_scale + g * 256, scr, lane); }
        }
        for (int row = gw; row < S_; row += ngw) rmsnorm_row(x + (size_t)row * D_, attn_g, H + (size_t)row * D_, lane);
    }
    if (nblk == 0x7fffffff) grid.sync();
    GRID_BAR();
    {
        pg8::Gemm g{H, WinT, S_, ZLD, D_, (size_t)256 * D_ * 2}; pg8::StaticOrder S; S.init(S_, ZLD, nblk, bid); EpiStoreBf16 E{Z, ZLD, KI};
#ifndef SKIP_G1
        pg8::gemm_phase<EpiStoreBf16, pg8::StaticOrder, true, true>(lds, g, S, E, wave);
#endif
#ifdef DUP_G1
        pg8::gemm_phase<EpiStoreBf16, pg8::StaticOrder, true, true>(lds, g, S, E, wave);
#endif
    }
    GRID_BAR();
    {
        PHASE_IDS();
#pragma unroll 1
        for (int step2 = 0; step2 < 2; ++step2) {
        if ((step2 ^ (bid & 1)) == 0) {
#ifdef DUP_P2A
        for (int rep2 = 0; rep2 < 2; ++rep2)
#endif
        for (size_t it = (size_t)bid * 512 + tid; it < (size_t)S_ * 128; it += (size_t)nblk * 512) {
            const int t = (int)(it >> 7), c = ((int)it & 127) * 8, g = c >> 8, w = 2 << g;
            const int lo = (t + 1 - w) > 0 ? (t + 1 - w) : 0; const float inv = 1.f / (float)(t + 1 - lo);
            float s[8] = {0.f, 0.f, 0.f, 0.f, 0.f, 0.f, 0.f, 0.f}; u32x4 v = {0u, 0u, 0u, 0u};
            for (int tt = lo; tt <= t; ++tt) { v = *(const u32x4*)(Z + (size_t)tt * ZLD + c);
                s[0] += bf_lo(v.x); s[1] += bf_hi(v.x); s[2] += bf_lo(v.y); s[3] += bf_hi(v.y); s[4] += bf_lo(v.z); s[5] += bf_hi(v.z); s[6] += bf_lo(v.w); s[7] += bf_hi(v.w); }
            u32x4 o; o.x = cvt_pk_bf16(s[0] * inv - bf_lo(v.x), s[1] * inv - bf_hi(v.x)); o.y = cvt_pk_bf16(s[2] * inv - bf_lo(v.y), s[3] * inv - bf_hi(v.y));
            o.z = cvt_pk_bf16(s[4] * inv - bf_lo(v.z), s[5] * inv - bf_hi(v.z)); o.w = cvt_pk_bf16(s[6] * inv - bf_lo(v.w), s[7] * inv - bf_hi(v.w));
            *(u32x4*)(Dp + ((size_t)g * S_ + t) * 256 + (c & 255)) = o;
        }
        {
            const int d0 = (lane & 7) * 16;
            float gq[16];
#pragma unroll
            for (int e = 0; e < 16; ++e) gq[e] = qn_g[d0 + e] * kn_g[d0 + e] * 0.08838834764831845f;
            for (int t = gw; t < S_; t += ngw) {
#pragma unroll
                for (int which = 0; which < 2; ++which) {
                    u32x4* ptr = (u32x4*)(Z + (size_t)t * ZLD + (which ? OFF_K : OFF_Q) + lane * 16);
                    const u32x4 a = ptr[0], b = ptr[1];
                    float f[16] = {bf_lo(a.x), bf_hi(a.x), bf_lo(a.y), bf_hi(a.y), bf_lo(a.z), bf_hi(a.z), bf_lo(a.w), bf_hi(a.w), bf_lo(b.x), bf_hi(b.x), bf_lo(b.y), bf_hi(b.y), bf_lo(b.z), bf_hi(b.z), bf_lo(b.w), bf_hi(b.w)};
                    float ss = 0.f;
#pragma unroll
                    for (int e = 0; e < 16; ++e) ss = fmaf(f[e], f[e], ss);
                    ss += __shfl_xor(ss, 1); ss += __shfl_xor(ss, 2); ss += __shfl_xor(ss, 4);
                    const float rinv = 1.f / sqrtf(ss * (1.f / 128.f) + EPS_);
#pragma unroll
                    for (int e = 0; e < 16; ++e) f[e] = f[e] * rinv * (which ? 1.f : gq[e]);
                    if (which == 0) {
                        u32x4 oa, ob; oa.x = cvt_pk_bf16(f[0], f[1]); oa.y = cvt_pk_bf16(f[2], f[3]); oa.z = cvt_pk_bf16(f[4], f[5]); oa.w = cvt_pk_bf16(f[6], f[7]);
                        ob.x = cvt_pk_bf16(f[8], f[9]); ob.y = cvt_pk_bf16(f[10], f[11]); ob.z = cvt_pk_bf16(f[12], f[13]); ob.w = cvt_pk_bf16(f[14], f[15]);
                        ptr[0] = oa; ptr[1] = ob;
                    } else {
                        int w0 = 0, w1 = 0, w2 = 0, w3 = 0;
                        w0 = __builtin_amdgcn_cvt_pk_fp8_f32(f[0], f[1], w0, false); w0 = __builtin_amdgcn_cvt_pk_fp8_f32(f[2], f[3], w0, true);
                        w1 = __builtin_amdgcn_cvt_pk_fp8_f32(f[4], f[5], w1, false); w1 = __builtin_amdgcn_cvt_pk_fp8_f32(f[6], f[7], w1, true);
                        w2 = __builtin_amdgcn_cvt_pk_fp8_f32(f[8], f[9], w2, false); w2 = __builtin_amdgcn_cvt_pk_fp8_f32(f[10], f[11], w2, true);
                        w3 = __builtin_amdgcn_cvt_pk_fp8_f32(f[12], f[13], w3, false); w3 = __builtin_amdgcn_cvt_pk_fp8_f32(f[14], f[15], w3, true);
                        u32x4 o8; o8.x = (unsigned)w0; o8.y = (unsigned)w1; o8.z = (unsigned)w2; o8.w = (unsigned)w3;
                        *(u32x4*)(KV8 + (size_t)t * 2048 + lane * 16) = o8;
                    }
                }
                {
                    const u32x4* ptr = (const u32x4*)(Z + (size_t)t * ZLD + OFF_V + lane * 16);
                    const u32x4 a = ptr[0], b = ptr[1];
                    int w0 = 0, w1 = 0, w2 = 0, w3 = 0;
                    w0 = __builtin_amdgcn_cvt_pk_fp8_f32(bf_lo(a.x), bf_hi(a.x), w0, false); w0 = __builtin_amdgcn_cvt_pk_fp8_f32(bf_lo(a.y), bf_hi(a.y), w0, true);
                    w1 = __builtin_amdgcn_cvt_pk_fp8_f32(bf_lo(a.z), bf_hi(a.z), w1, false); w1 = __builtin_amdgcn_cvt_pk_fp8_f32(bf_lo(a.w), bf_hi(a.w), w1, true);
                    w2 = __builtin_amdgcn_cvt_pk_fp8_f32(bf_lo(b.x), bf_hi(b.x), w2, false); w2 = __builtin_amdgcn_cvt_pk_fp8_f32(bf_lo(b.y), bf_hi(b.y), w2, true);
                    w3 = __builtin_amdgcn_cvt_pk_fp8_f32(bf_lo(b.z), bf_hi(b.z), w3, false); w3 = __builtin_amdgcn_cvt_pk_fp8_f32(bf_lo(b.w), bf_hi(b.w), w3, true);
                    u32x4 o8; o8.x = (unsigned)w0; o8.y = (unsigned)w1; o8.z = (unsigned)w2; o8.w = (unsigned)w3;
                    *(u32x4*)(KV8 + (size_t)t * 2048 + 1024 + lane * 16) = o8;
                }
            }
        }
        } else {
        {
            __syncthreads();
#ifdef DUP_IDX
            for (int rep = 0; rep < 2; ++rep)
#endif
            for (int base = 0; base < 512; base += nblk) {
                const int i = base + bid;
                if (i < 512) {
#ifndef SKIP_IDX
                    indexer_block16(Z, KI, SEL, i, lds, wave);
                    indexer_block16(Z, KI, SEL, 1023 - i, lds, wave);
#endif
                }
            }
        }
        }
        }
    }
    GRID_BAR();
    {
        int kpool = 256; asm volatile("" : "+s"(kpool));
        pg8::Gemm g{Dp, PwT, 4 * S_, 1024, kpool, (size_t)256 * 256 * 2}; PoolOrder S{nblk, bid}; EpiPool E{YMIX};
#ifndef SKIP_G3
        pg8::gemm_phase<EpiPool, PoolOrder, true, true>(lds, g, S, E, wave);
#endif
        __syncthreads();
        LAS float* sbuf = (LAS float*)lds + wave * 2048;
#ifndef SKIP_ATT
        for (int t = gw; t < S_; t += ngw) attn_query8(KV8, Z, SEL, YMIX, t, sbuf);
#endif
#ifdef DUP_ATT
        for (int t = gw; t < S_; t += ngw) attn_query8(KV8, Z, SEL, YMIX, t, sbuf);
#endif
    }
    GRID_BAR();
    {
        pg8::Gemm g{YMIX, WoutT, S_, D_, D_, (size_t)256 * D_ * 2}; pg8::StaticOrder S; S.init(S_, D_, nblk, bid); EpiResid E{x, out};
#ifndef SKIP_G4
        pg8::gemm_phase<EpiResid, pg8::StaticOrder, true, true>(lds, g, S, E, wave);
#endif
#ifdef DUP_G4
        pg8::gemm_phase<EpiResid, pg8::StaticOrder, true, true>(lds, g, S, E, wave);
#endif
    }
    GRID_BAR();
    {
        PHASE_IDS();
#ifdef DUP_P5
        for (int rep5 = 0; rep5 < 2; ++rep5)
#endif
        for (int row = gw; row < S_; row += ngw) rmsnorm_row(out + (size_t)row * D_, ffn_g, H + (size_t)row * D_, lane);
        if (bid == 0) { u32x4 z = {0u, 0u, 0u, 0u};
            for (int i = tid; i < 2 * D_ / 8; i += 512) ((u32x4*)Hb)[i] = z;
            for (int i = tid; i < 126 * D_ / 8; i += 512) ((u32x4*)(H + (size_t)S_ * D_))[i] = z; }
    }
    GRID_BAR();
    {
        pg8::Gemm g{Hb, WupT, UP_TILES * 256, 2 * DFF, D_, (size_t)UP_ROWS * D_ * 2}; pg8::StaticOrder S; S.init(UP_TILES * 256, 2 * DFF, nblk, bid);
        EpiUp E{ACT, conv_w, conv_b, (LAS f32x4*)(lds + LDS_XL)};
#ifndef SKIP_G6
        pg8::gemm_phase<EpiUp, pg8::StaticOrder, true, true>(lds, g, S, E, wave);
#endif
#ifdef DUP_G6
        pg8::gemm_phase<EpiUp, pg8::StaticOrder, true, true>(lds, g, S, E, wave);
#endif
    }
    GRID_BAR();
    {
        pg8::Gemm g{ACT, WdT, S_, D_, DFF, (size_t)256 * DFF * 2}; pg8::StaticOrder S; S.init(S_, D_, nblk, bid); EpiResid E{out, out};
#ifndef SKIP_G7
        pg8::gemm_phase<EpiResid, pg8::StaticOrder, true, true>(lds, g, S, E, wave);
#endif
    }
}

extern "C" void kernel_launch(void* const* d_in, const int* in_sizes, int n_in, void* d_out, int out_size, void* d_ws, size_t ws_size, hipStream_t stream) {
    static int grid = 0;
    if (grid == 0) {
        if (n_in != 13 || in_sizes[0] != S_ * D_ || out_size != S_ * D_ || ws_size < WS_END) { fprintf(stderr, "kernel_launch: unexpected shapes (n_in %d, ws %zu, need %zu)\n", n_in, ws_size, (size_t)WS_END); grid = -1; return; }
        int dev = 0, cus = 0, per_cu = 0;
        if (hipGetDevice(&dev) != hipSuccess || hipDeviceGetAttribute(&cus, hipDeviceAttributeMultiprocessorCount, dev) != hipSuccess) { grid = -1; return; }
        if (hipFuncSetAttribute((const void*)mega, hipFuncAttributeMaxDynamicSharedMemorySize, LDS_BYTES) != hipSuccess) { fprintf(stderr, "kernel_launch: hipFuncSetAttribute failed\n"); grid = -1; return; }
        if (hipOccupancyMaxActiveBlocksPerMultiprocessor(&per_cu, (const void*)mega, 512, LDS_BYTES) != hipSuccess || per_cu < 1) { fprintf(stderr, "kernel_launch: occupancy query failed (%d)\n", per_cu); (void)hipGetLastError(); per_cu = 1; }
        grid = cus * per_cu;
    }
    if (grid < 0) return;
    Params p{};
    for (int i = 0; i < 13; ++i) p.in[i] = (const float*)d_in[i];
    p.out = (float*)d_out; p.ws = (unsigned char*)d_ws;
    if (hipMemsetAsync((char*)d_ws + WS_BAR, 0, 16384, stream) != hipSuccess) { fprintf(stderr, "kernel_launch: memset of the barrier words failed\n"); return; }
    void* args[] = {&p};
    const hipError_t e = hipLaunchCooperativeKernel((const void*)mega, dim3(grid), dim3(512), args, LDS_BYTES, stream);
    if (e != hipSuccess) fprintf(stderr, "kernel_launch: cooperative launch failed: %s (grid %d)\n", hipGetErrorString(e), grid);
}
```
